# Optimizing an MI355X kernel written in HIP

```python
import math
import jax, jax.numpy as jnp
from jax import lax
import numpy as np

D_MODEL = 4096
BATCH = 4
SEQ = 4096
DEPTH = 1

D_MIX = D_MODEL
D_ATTN = D_MIX // 2
D_SSM = D_MIX - D_ATTN
HEAD_DIM = 64
N_Q_HEADS = D_ATTN // HEAD_DIM
N_KV_HEADS = max(1, N_Q_HEADS // 8)
Q_PER_KV = N_Q_HEADS // N_KV_HEADS
D_KV = N_KV_HEADS * HEAD_DIM
WINDOW = 128
BLOCK = WINDOW
ROPE_THETA = 10000.0
SSM_GROUP = 16
N_SSM_GROUPS = D_SSM // SSM_GROUP
STATE = 64
DT_MIN = 1e-3
DT_MAX = 1e-1
D_FF = 4 * D_MODEL
N_MOD = 6
EPS = 1e-6
D_IN = D_ATTN + 2 * D_KV + D_SSM

kernel_name = "hymba_s5_swa_sink_adaln_block"


def rmsnorm(x, g):
    xf = x.astype(jnp.float32)
    y = xf * lax.rsqrt(jnp.mean(xf * xf, axis=-1, keepdims=True) + EPS)
    return (y * g.astype(jnp.float32)).astype(x.dtype)


def rope(x):
    s = x.shape[1]
    half = x.shape[-1] // 2
    inv_freq = ROPE_THETA ** (-jnp.arange(half, dtype=jnp.float32) / half)
    ang = jnp.arange(s, dtype=jnp.float32)[:, None] * inv_freq[None, :]
    cos = jnp.cos(ang)[None, :, None, :]
    sin = jnp.sin(ang)[None, :, None, :]
    xf = x.astype(jnp.float32)
    x1, x2 = xf[..., :half], xf[..., half:]
    out = jnp.concatenate([x1 * cos - x2 * sin, x2 * cos + x1 * sin], axis=-1)
    return out.astype(x.dtype)


def sliding_window_attention(q, k, v, sinks):
    b, s = q.shape[0], q.shape[1]
    nb = s // BLOCK
    qb = q.reshape(b, nb, BLOCK, N_KV_HEADS, Q_PER_KV, HEAD_DIM).astype(jnp.float32)
    kb = k.reshape(b, nb, BLOCK, N_KV_HEADS, HEAD_DIM).astype(jnp.float32)
    vb = v.reshape(b, nb, BLOCK, N_KV_HEADS, HEAD_DIM).astype(jnp.float32)
    kk = jnp.concatenate([jnp.concatenate([jnp.zeros_like(kb[:, :1]), kb[:, :-1]], axis=1), kb], axis=2)
    vv = jnp.concatenate([jnp.concatenate([jnp.zeros_like(vb[:, :1]), vb[:, :-1]], axis=1), vb], axis=2)
    scores = jnp.einsum('bnqhgd,bnkhd->bnhgqk', qb, kk) * (HEAD_DIM ** -0.5)
    qi = jnp.arange(BLOCK)[:, None] + BLOCK
    kj = jnp.arange(2 * BLOCK)[None, :]
    rel = qi - kj
    band = (rel >= 0) & (rel < WINDOW)
    key_ok = (jnp.arange(nb)[:, None] > 0) | (jnp.arange(2 * BLOCK)[None, :] >= BLOCK)
    mask = band[None, :, :] & key_ok[:, None, :]
    scores = jnp.where(mask[None, :, None, None], scores, jnp.float32(-1e30))
    sink = sinks.astype(jnp.float32).reshape(N_KV_HEADS, Q_PER_KV)[None, None, :, :, None, None]
    m = jnp.maximum(jnp.max(scores, axis=-1, keepdims=True), sink)
    p = jnp.exp(scores - m)
    probs = p / (jnp.sum(p, axis=-1, keepdims=True) + jnp.exp(sink - m))
    out = jnp.einsum('bnhgqk,bnkhd->bnqhgd', probs, vv)
    return out.reshape(b, s, N_Q_HEADS * HEAD_DIM).astype(q.dtype)


def _scan_op(e1, e2):
    a1, b1 = e1
    a2, b2 = e2
    return a2 * a1, a2 * b1 + b2


def s5_mixer(u, lam_re, lam_im, log_step, b_re, b_im, c_re, c_im, d_skip, w_glu, b_glu):
    bsz, s = u.shape[0], u.shape[1]
    f32 = jnp.float32
    uf = u.astype(f32).reshape(bsz, s, N_SSM_GROUPS, SSM_GROUP)
    step = jnp.exp(log_step.astype(f32))[:, None]
    lam = lax.complex(lam_re.astype(f32), lam_im.astype(f32))
    lam_bar = jnp.exp(lam * step)
    coef = (lam_bar - 1.0) / lam
    b_bar = coef[..., None] * lax.complex(b_re.astype(f32), b_im.astype(f32))
    bu = jnp.einsum('bsgh,gph->sbgp', uf.astype(jnp.complex64), b_bar)
    a = jnp.broadcast_to(lam_bar[None, None], (s, 1, N_SSM_GROUPS, STATE))
    _, states = lax.associative_scan(_scan_op, (a, bu), axis=0)
    c_mat = lax.complex(c_re.astype(f32), c_im.astype(f32))
    y = jnp.real(jnp.einsum('sbgp,ghp->bsgh', states, c_mat))
    y = y + d_skip.astype(f32).reshape(N_SSM_GROUPS, SSM_GROUP) * uf
    y = jax.nn.gelu(y.reshape(bsz, s, D_SSM), approximate=False)
    out = y * jax.nn.sigmoid(y @ w_glu.astype(f32) + b_glu.astype(f32))
    return out.astype(u.dtype)


def setup_inputs(seed: int = 0) -> dict:
    key = jax.random.key(seed)
    ks = jax.random.split(key, 24)
    f32 = jnp.float32
    nrm = lambda k, shape, sc: jax.random.normal(k, shape, f32) * sc
    inputs = {
        "x": nrm(ks[0], (BATCH, SEQ, D_MODEL), 1.0),
        "c": nrm(ks[1], (BATCH, D_MODEL), 1.0),
        "w_ada": nrm(ks[2], (DEPTH, D_MODEL, N_MOD * D_MODEL), 0.5 * D_MODEL ** -0.5),
        "b_ada": nrm(ks[3], (DEPTH, N_MOD * D_MODEL), 0.01),
        "norm1_g": 1.0 + nrm(ks[4], (DEPTH, D_MODEL), 0.02),
        "w_in": nrm(ks[5], (DEPTH, D_MODEL, D_IN), D_MODEL ** -0.5),
        "sinks": nrm(ks[6], (DEPTH, N_Q_HEADS), 0.5),
        "ssm_lam_re": -0.5 + nrm(ks[7], (DEPTH, N_SSM_GROUPS, STATE), 0.01),
        "ssm_lam_im": jnp.pi * jnp.arange(STATE, dtype=f32)[None, None, :] + nrm(ks[8], (DEPTH, N_SSM_GROUPS, STATE), 0.01),
        "ssm_log_step": jax.random.uniform(ks[9], (DEPTH, N_SSM_GROUPS), f32, math.log(DT_MIN), math.log(DT_MAX)),
        "ssm_b_re": nrm(ks[10], (DEPTH, N_SSM_GROUPS, STATE, SSM_GROUP), (2 * SSM_GROUP) ** -0.5),
        "ssm_b_im": nrm(ks[11], (DEPTH, N_SSM_GROUPS, STATE, SSM_GROUP), (2 * SSM_GROUP) ** -0.5),
        "ssm_c_re": nrm(ks[12], (DEPTH, N_SSM_GROUPS, SSM_GROUP, STATE), (2 * STATE) ** -0.5),
        "ssm_c_im": nrm(ks[13], (DEPTH, N_SSM_GROUPS, SSM_GROUP, STATE), (2 * STATE) ** -0.5),
        "ssm_d": nrm(ks[14], (DEPTH, D_SSM), 1.0),
        "w_glu": nrm(ks[15], (DEPTH, D_SSM, D_SSM), D_SSM ** -0.5),
        "b_glu": nrm(ks[16], (DEPTH, D_SSM), 0.01),
        "attn_out_g": 1.0 + nrm(ks[17], (DEPTH, D_ATTN), 0.02),
        "ssm_out_g": 1.0 + nrm(ks[18], (DEPTH, D_SSM), 0.02),
        "w_out": nrm(ks[19], (DEPTH, D_MIX, D_MODEL), D_MIX ** -0.5),
        "norm2_g": 1.0 + nrm(ks[20], (DEPTH, D_MODEL), 0.02),
        "w_ff1": nrm(ks[21], (DEPTH, D_MODEL, D_FF), D_MODEL ** -0.5),
        "w_ff2": nrm(ks[22], (DEPTH, D_FF, D_MODEL), D_FF ** -0.5),
        "final_g": 1.0 + nrm(ks[23], (D_MODEL,), 0.02),
    }
    return inputs


def reference(x, c, w_ada, b_ada, norm1_g, w_in, sinks, ssm_lam_re, ssm_lam_im, ssm_log_step,
              ssm_b_re, ssm_b_im, ssm_c_re, ssm_c_im, ssm_d, w_glu, b_glu, attn_out_g, ssm_out_g,
              w_out, norm2_g, w_ff1, w_ff2, final_g):
    bsz, s, _ = x.shape
    c_act = jax.nn.silu(c.astype(jnp.float32))
    for l in range(DEPTH):
        mod = (c_act @ w_ada[l].astype(jnp.float32) + b_ada[l].astype(jnp.float32)).astype(x.dtype)
        shift1, scale1, gate1, shift2, scale2, gate2 = [m[:, None, :] for m in jnp.split(mod, N_MOD, axis=-1)]

        h = rmsnorm(x, norm1_g[l]) * (1.0 + scale1) + shift1
        proj = h @ w_in[l]
        q = proj[..., :D_ATTN].reshape(bsz, s, N_Q_HEADS, HEAD_DIM)
        k = proj[..., D_ATTN:D_ATTN + D_KV].reshape(bsz, s, N_KV_HEADS, HEAD_DIM)
        v = proj[..., D_ATTN + D_KV:D_ATTN + 2 * D_KV].reshape(bsz, s, N_KV_HEADS, HEAD_DIM)
        u = proj[..., D_ATTN + 2 * D_KV:]
        attn = sliding_window_attention(rope(q), rope(k), v, sinks[l])
        ssm = s5_mixer(u, ssm_lam_re[l], ssm_lam_im[l], ssm_log_step[l], ssm_b_re[l], ssm_b_im[l],
                       ssm_c_re[l], ssm_c_im[l], ssm_d[l], w_glu[l], b_glu[l])
        mixed = jnp.concatenate([rmsnorm(attn, attn_out_g[l]), rmsnorm(ssm, ssm_out_g[l])], axis=-1)
        x = x + gate1 * (mixed @ w_out[l])

        h2 = rmsnorm(x, norm2_g[l]) * (1.0 + scale2) + shift2
        ff = jnp.square(jax.nn.relu(h2 @ w_ff1[l])) @ w_ff2[l]
        x = x + gate2 * ff
    return rmsnorm(x, final_g)
```

```cpp
#include <hip/hip_runtime.h>
#include <cstdio>
#include <cstdint>
namespace pg8 {
#define PG8_LAS __attribute__((address_space(3)))
typedef unsigned short bf16_t;
typedef short bf16x8 __attribute__((ext_vector_type(8)));
typedef float f32x4 __attribute__((ext_vector_type(4)));
typedef unsigned u32x4 __attribute__((ext_vector_type(4)));
constexpr int BM = 256, BK = 64, HALF = 128, HTB = HALF * BK * 2  , STAGE_BYTES = 8 * HTB, NXCD = 8, WGM = 8;

__host__ __device__ __forceinline__ int lds_byte(int r, int c) { const int st = (r >> 4) * 2 + (c >> 5), rr = r & 15, cc = c & 31, ob = rr * 64 + cc * 2; return st * 1024 + (ob ^ (((ob >> 9) & 1) << 5)); }
__host__ __device__ __forceinline__ void stage_rc(int b, int& R, int& C) { const int st = b / 1024, sb = b % 1024, swz = sb ^ (((sb >> 9) & 1) << 5); R = (st >> 1) * 16 + swz / 64; C = (st & 1) * 32 + (swz % 64) / 2; }
__host__ __device__ __forceinline__ int perm32(int rho) { const int n = rho >> 4, i = rho & 15; return 8 * (i >> 2) + 4 * n + (i & 3); }

struct Unit { int pm, pn; };
struct Gemm { const bf16_t* A; const bf16_t* Bt; int M, N, K; };

struct StaticOrder {
    int nM, nN, nwg, G, c;
    __host__ __device__ void init(int M, int N, int G_, int c_) { nM = M / BM; nN = N / BM; nwg = nM * nN; G = G_; c = c_; }
    __host__ __device__ bool next(int i, Unit& u) const {
        const long L = (long)i * G + c; if (L >= nwg) return false;
        int wgid = (int)L; { const int q = nwg / NXCD, r = nwg % NXCD, xcd = wgid % NXCD, off = wgid / NXCD; wgid = (xcd < r ? xcd * (q + 1) : r * (q + 1) + (xcd - r) * q) + off; }
        const int nig = WGM * nN, gid = wgid / nig, fm = gid * WGM, gsz = (nM - fm) < WGM ? (nM - fm) : WGM;
        u.pm = fm + ((wgid % nig) % gsz); u.pn = (wgid % nig) / gsz; return true;
    }
    __device__ __forceinline__ void a_ready(const Unit&) const {}
    __device__ __forceinline__ void done(const Unit&) const {}
};

__device__ __forceinline__ unsigned cvt_pk_bf16(float lo, float hi) { unsigned r; asm volatile("v_cvt_pk_bf16_f32 %0, %1, %2" : "=v"(r) : "v"(lo), "v"(hi)); return r; }
typedef float f32x2 __attribute__((ext_vector_type(2)));
__device__ __forceinline__ f32x2 gelu_pk(f32x2 v) {
    const f32x2 av = __builtin_elementwise_abs(v), d = av * 0.2316418882f + 1.0f;
    f32x2 t; t.x = __builtin_amdgcn_rcpf(d.x); t.y = __builtin_amdgcn_rcpf(d.y);
    f32x2 q = t * 0.5307027145f + (-0.7265760135f); q = q * t + 0.7107068705f; q = q * t + (-0.142248368f); q = q * t + 0.127414796f; q = q * t;
    const f32x2 s = (v * v) * (-0.72134752044f);
    f32x2 e; e.x = __builtin_amdgcn_exp2f(s.x); e.y = __builtin_amdgcn_exp2f(s.y);
    const f32x2 m = v * (q * e), r = v - m;
    f32x2 o; o.x = v.x < 0.f ? m.x : r.x; o.y = v.y < 0.f ? m.y : r.y; return o;
}

typedef unsigned u32x2 __attribute__((ext_vector_type(2)));
struct EpiIn {
    static constexpr bool PERM = true, AFTER_DRAIN = false;
    bf16_t *Q, *K, *V, *U; const float* rcos; const float* rsin; float qscale;
    __device__ __forceinline__ void operator()(const f32x4 (&acc)[2][2][4][2], const Unit& u, int wr, int wc, int fr, int fq) const {
        const int row0 = u.pm * BM + wr * 64 + fr, tile = u.pn, cw = wc * 32 + 8 * fq;
        if (tile < 9) {
            bf16_t* dst = tile < 8 ? Q + tile * 256 : K; const int ldc = tile < 8 ? 2048 : 256; const float sc = tile < 8 ? qscale : 1.0f;
            const int f0 = 4 * (4 * (wc & 1) + fq);
#pragma unroll
            for (int ai = 0; ai < 2; ++ai)
#pragma unroll
                for (int m = 0; m < 4; ++m) { const int row = row0 + ai * HALF + m * 16, pos = row & 4095;
                    const f32x4 cs = *(const f32x4*)(rcos + pos * 32 + f0) * sc, sn = *(const f32x4*)(rsin + pos * 32 + f0) * sc;
                    bf16_t* rowp = dst + (size_t)row * ldc + cw;
#pragma unroll
                    for (int bj = 0; bj < 2; ++bj) { const f32x4 x1 = acc[ai][bj][m][0], x2 = acc[ai][bj][m][1];
                        const f32x4 o1 = x1 * cs - x2 * sn, o2 = x2 * cs + x1 * sn;
                        u32x4 w; w.x = cvt_pk_bf16(o1[0], o1[1]); w.y = cvt_pk_bf16(o1[2], o1[3]); w.z = cvt_pk_bf16(o2[0], o2[1]); w.w = cvt_pk_bf16(o2[2], o2[3]);
                        *(u32x4*)(rowp + bj * HALF) = w; } }
        } else {
            bf16_t* dst = tile == 9 ? V : U + (tile - 10) * 256; const int ldc = tile == 9 ? 256 : 2048;
#pragma unroll
            for (int ai = 0; ai < 2; ++ai)
#pragma unroll
                for (int m = 0; m < 4; ++m) { bf16_t* rowp = dst + (size_t)(row0 + ai * HALF + m * 16) * ldc + cw;
#pragma unroll
                    for (int bj = 0; bj < 2; ++bj) { const f32x4 v0 = acc[ai][bj][m][0], v1 = acc[ai][bj][m][1];
                        u32x4 w; w.x = cvt_pk_bf16(v0[0], v0[1]); w.y = cvt_pk_bf16(v0[2], v0[3]); w.z = cvt_pk_bf16(v1[0], v1[1]); w.w = cvt_pk_bf16(v1[2], v1[3]);
                        *(u32x4*)(rowp + bj * HALF) = w; } }
        }
    }
};
__device__ __forceinline__ float bf_lo(unsigned w) { return __builtin_bit_cast(float, w << 16); }
__device__ __forceinline__ float bf_hi(unsigned w) { return __builtin_bit_cast(float, w & 0xffff0000u); }
struct EpiGlu {
    static constexpr bool PERM = true, AFTER_DRAIN = false;
    const bf16_t* YG; const float* bias; bf16_t* O; float* SS;
    __device__ __forceinline__ void operator()(const f32x4 (&acc)[2][2][4][2], const Unit& u, int wr, int wc, int fr, int fq) const {
        const int row0 = u.pm * BM + wr * 64 + fr, col0 = u.pn * BM + wc * 32 + 8 * fq;
        f32x4 bv[2][2];
#pragma unroll
        for (int bj = 0; bj < 2; ++bj)
#pragma unroll
            for (int n = 0; n < 2; ++n) bv[bj][n] = *(const f32x4*)(bias + col0 + bj * HALF + 4 * n);
#pragma unroll
        for (int ai = 0; ai < 2; ++ai)
#pragma unroll
            for (int m = 0; m < 4; ++m) { const int row = row0 + ai * HALF + m * 16; float ss = 0.f;
#pragma unroll
                for (int bj = 0; bj < 2; ++bj) { const u32x4 yw = *(const u32x4*)(YG + (size_t)row * 2048 + col0 + bj * HALF);
                    const f32x4 z0 = acc[ai][bj][m][0] + bv[bj][0], z1 = acc[ai][bj][m][1] + bv[bj][1];
                    float o[8]; const float y[8] = {bf_lo(yw.x), bf_hi(yw.x), bf_lo(yw.y), bf_hi(yw.y), bf_lo(yw.z), bf_hi(yw.z), bf_lo(yw.w), bf_hi(yw.w)};
#pragma unroll
                    for (int e = 0; e < 4; ++e) { o[e] = y[e] * __builtin_amdgcn_rcpf(1.0f + __builtin_amdgcn_exp2f(-1.4426950408889634f * z0[e]));
                                                  o[4 + e] = y[4 + e] * __builtin_amdgcn_rcpf(1.0f + __builtin_amdgcn_exp2f(-1.4426950408889634f * z1[e])); }
#pragma unroll
                    for (int e = 0; e < 8; ++e) ss += o[e] * o[e];
                    u32x4 w; w.x = cvt_pk_bf16(o[0], o[1]); w.y = cvt_pk_bf16(o[2], o[3]); w.z = cvt_pk_bf16(o[4], o[5]); w.w = cvt_pk_bf16(o[6], o[7]);
                    *(u32x4*)(O + (size_t)row * 4096 + 2048 + col0 + bj * HALF) = w; }
                ss += __shfl_xor(ss, 16); ss += __shfl_xor(ss, 32);
                if (fq == 0) SS[(size_t)row * 32 + u.pn * 4 + wc] = ss; }
    }
};
struct EpiRes {
    static constexpr bool PERM = false, AFTER_DRAIN = false;
    const float* base; float* out; const float* gate;
    __device__ __forceinline__ void operator()(const f32x4 (&acc)[2][2][4][2], const Unit& u, int wr, int wc, int fr, int fq) const {
        const int row0 = u.pm * BM + wr * 64 + fr, col0 = u.pn * BM + wc * 32 + 4 * fq; const float* gp = gate + (size_t)((u.pm * BM) >> 12) * 24576 + col0;
        f32x4 gv[2][2];
#pragma unroll
        for (int bj = 0; bj < 2; ++bj)
#pragma unroll
            for (int n = 0; n < 2; ++n) gv[bj][n] = *(const f32x4*)(gp + bj * HALF + n * 16);
#pragma unroll
        for (int ai = 0; ai < 2; ++ai)
#pragma unroll
            for (int m = 0; m < 4; ++m) { const size_t off = (size_t)(row0 + ai * HALF + m * 16) * 4096 + col0;
#pragma unroll
                for (int bj = 0; bj < 2; ++bj)
#pragma unroll
                    for (int n = 0; n < 2; ++n) { const f32x4 b = *(const f32x4*)(base + off + bj * HALF + n * 16); *(f32x4*)(out + off + bj * HALF + n * 16) = b + gv[bj][n] * acc[ai][bj][m][n]; } }
    }
};
struct EpiSqRelu {
    static constexpr bool PERM = true, AFTER_DRAIN = false;
    bf16_t* O; int ldc;
    __device__ __forceinline__ void operator()(const f32x4 (&acc)[2][2][4][2], const Unit& u, int wr, int wc, int fr, int fq) const {
        const int row0 = u.pm * BM + wr * 64 + fr, col0 = u.pn * BM + wc * 32 + 8 * fq;
#pragma unroll
        for (int ai = 0; ai < 2; ++ai)
#pragma unroll
            for (int m = 0; m < 4; ++m) { bf16_t* rowp = O + (size_t)(row0 + ai * HALF + m * 16) * ldc + col0;
#pragma unroll
                for (int bj = 0; bj < 2; ++bj) { f32x4 v0 = acc[ai][bj][m][0], v1 = acc[ai][bj][m][1];
#pragma unroll
                    for (int e = 0; e < 4; ++e) { const float a = fmaxf(v0[e], 0.f), b = fmaxf(v1[e], 0.f); v0[e] = a * a; v1[e] = b * b; }
                    u32x4 w; w.x = cvt_pk_bf16(v0[0], v0[1]); w.y = cvt_pk_bf16(v0[2], v0[3]); w.z = cvt_pk_bf16(v1[0], v1[1]); w.w = cvt_pk_bf16(v1[2], v1[3]);
                    *(u32x4*)(rowp + bj * HALF) = w; } }
    }
};

template <class Epi, class Sched, bool ALIGN_EPI = false, bool SP2 = false>
__device__ __forceinline__ void gemm_phase(PG8_LAS unsigned char* lds, const Gemm g, const Sched& S, const Epi& E) {
    const int tid = threadIdx.x, wid = __builtin_amdgcn_readfirstlane(tid >> 6), lane = tid & 63, wr = wid >> 2, wc = wid & 3, fr = lane & 15, fq = lane >> 4;
    const int K = g.K, nt = K / BK;
    unsigned voffA[2], voffB[2];
#pragma unroll
    for (int i = 0; i < 2; ++i) { int R, C; stage_rc(tid * 16 + i * 8192, R, C); const int Rb = Epi::PERM ? ((R & ~31) + perm32(R & 31)) : R;
        voffA[i] = (unsigned)(R * K + C) * 2u; voffB[i] = (unsigned)(Rb * K + C) * 2u; }
    const size_t kstep = (size_t)(BK * 2);
    const size_t hstep = (size_t)HALF * K * 2;
    const size_t tstep = 2 * hstep;
    const unsigned ldsw = (unsigned)wid * 1024u;
    const int aoff = lds_byte(wr * 64 + fr, fq * 8), boff = lds_byte(wc * 32 + fr, fq * 8);
#define PG8_SA(b, h) (((b) * 2 + (h)) * HTB)
#define PG8_SB(b, h) ((4 + (b) * 2 + (h)) * HTB)
#define PG8_STAGE(bufoff, gbase, voff) do { _Pragma("unroll") for (int _i = 0; _i < 2; ++_i) \
        __builtin_amdgcn_global_load_lds((const unsigned*)((const char*)(gbase) + (voff)[_i]), (PG8_LAS unsigned*)(lds + (bufoff) + ldsw + _i * 8192), 16, 0, 0); } while (0)
#define PG8_LDA(dst, b, h) do { _Pragma("unroll") for (int m = 0; m < 4; ++m) _Pragma("unroll") for (int k = 0; k < 2; ++k) dst[m][k] = *(const PG8_LAS bf16x8*)(lds + PG8_SA(b, h) + aoff + m * 2048 + k * 1024); } while (0)
#define PG8_LDB(dst, b, h) do { _Pragma("unroll") for (int n = 0; n < 2; ++n) _Pragma("unroll") for (int k = 0; k < 2; ++k) dst[n][k] = *(const PG8_LAS bf16x8*)(lds + PG8_SB(b, h) + boff + n * 2048 + k * 1024); } while (0)
#define PG8_MMA(ai, bj, At, Bt) do { __builtin_amdgcn_s_setprio(1); _Pragma("unroll") for (int m = 0; m < 4; ++m) _Pragma("unroll") for (int n = 0; n < 2; ++n) _Pragma("unroll") for (int k = 0; k < 2; ++k) \
        acc[ai][bj][m][n] = __builtin_amdgcn_mfma_f32_16x16x32_bf16(Bt[n][k], At[m][k], acc[ai][bj][m][n], 0, 0, 0); __builtin_amdgcn_s_setprio(0); } while (0)
#define PG8_WAIT_V(n) asm volatile("s_waitcnt vmcnt(" #n ")" ::: "memory")
#define PG8_WAIT_L(n) asm volatile("s_waitcnt lgkmcnt(" #n ")" ::: "memory")
#define PG8_BAR __builtin_amdgcn_s_barrier()
#define PG8_SCHED __builtin_amdgcn_sched_barrier(0)
    Unit cur, nxt; int ui = 0;
    if (!S.next(0, cur)) return;
    f32x4 acc[2][2][4][2];
#pragma unroll
    for (int a = 0; a < 2; ++a)
#pragma unroll
        for (int b = 0; b < 2; ++b)
#pragma unroll
            for (int m = 0; m < 4; ++m)
#pragma unroll
                for (int n = 0; n < 2; ++n) acc[a][b][m][n] = (f32x4){0.f, 0.f, 0.f, 0.f};
    bf16x8 At[4][2], B0[2][2], B1[2][2];
    const char* cA = (const char*)g.A + (size_t)cur.pm * tstep; const char* cB = (const char*)g.Bt + (size_t)cur.pn * tstep;
    S.a_ready(cur);
    if constexpr (SP2) {
        PG8_STAGE(PG8_SB(0, 0), cB, voffB); PG8_STAGE(PG8_SB(0, 1), cB + hstep, voffB); PG8_STAGE(PG8_SA(0, 0), cA, voffA); PG8_STAGE(PG8_SA(0, 1), cA + hstep, voffA);
        if (wr == 1) PG8_BAR;
        PG8_WAIT_V(2); PG8_BAR;
        PG8_STAGE(PG8_SB(1, 0), cB + kstep, voffB); PG8_STAGE(PG8_SA(1, 0), cA + kstep, voffA); PG8_STAGE(PG8_SB(1, 1), cB + hstep + kstep, voffB);
        PG8_WAIT_V(6); PG8_BAR;
    } else {
        PG8_STAGE(PG8_SB(0, 0), cB, voffB); PG8_STAGE(PG8_SA(0, 0), cA, voffA); PG8_STAGE(PG8_SB(0, 1), cB + hstep, voffB); PG8_STAGE(PG8_SA(0, 1), cA + hstep, voffA);
        if (wr == 1) PG8_BAR;
        PG8_WAIT_V(4); PG8_BAR;
        PG8_STAGE(PG8_SB(1, 0), cB + kstep, voffB); PG8_STAGE(PG8_SA(1, 0), cA + kstep, voffA); PG8_STAGE(PG8_SB(1, 1), cB + hstep + kstep, voffB);
        PG8_WAIT_V(6); PG8_BAR;
    }
    for (;;) {
        const bool has_next = S.next(ui + 1, nxt);
        const char* nA = has_next ? (const char*)g.A + (size_t)nxt.pm * tstep : cA; const char* nB = has_next ? (const char*)g.Bt + (size_t)nxt.pn * tstep : cB;
        for (int t = 0; t < nt; t += 2) {
            const bool last = (t == nt - 2);
            const char* a1 = cA + (size_t)(t + 1) * kstep;
            const char* a2 = last ? nA : cA + (size_t)(t + 2) * kstep; const char* b2 = last ? nB : cB + (size_t)(t + 2) * kstep;
            const char* a3 = a2 + kstep; const char* b3 = b2 + kstep;
            if (last && has_next) S.a_ready(nxt);
            if constexpr (SP2) {
            PG8_LDB(B0, 0, 0); PG8_LDB(B1, 0, 1); PG8_SCHED; PG8_LDA(At, 0, 0); PG8_STAGE(PG8_SA(1, 1), a1 + hstep, voffA);
            PG8_WAIT_V(8); PG8_WAIT_L(0); PG8_BAR; PG8_MMA(0, 0, At, B0); PG8_MMA(0, 1, At, B1); PG8_BAR; PG8_SCHED;
            PG8_LDA(At, 0, 1); PG8_STAGE(PG8_SB(0, 0), b2, voffB); PG8_STAGE(PG8_SB(0, 1), b2 + hstep, voffB); PG8_STAGE(PG8_SA(0, 0), a2, voffA);
            PG8_WAIT_V(8); PG8_WAIT_L(0); PG8_BAR; PG8_MMA(1, 0, At, B0); PG8_MMA(1, 1, At, B1); PG8_BAR; PG8_SCHED;
            PG8_LDB(B0, 1, 0); PG8_LDB(B1, 1, 1); PG8_SCHED; PG8_LDA(At, 1, 0); PG8_STAGE(PG8_SA(0, 1), a2 + hstep, voffA);
            PG8_WAIT_V(8); PG8_WAIT_L(0); PG8_BAR; PG8_MMA(0, 0, At, B0); PG8_MMA(0, 1, At, B1); PG8_BAR; PG8_SCHED;
            PG8_LDA(At, 1, 1); PG8_STAGE(PG8_SB(1, 0), b3, voffB); PG8_STAGE(PG8_SB(1, 1), b3 + hstep, voffB); PG8_STAGE(PG8_SA(1, 0), a3, voffA);
            PG8_WAIT_V(8); PG8_WAIT_L(0); PG8_BAR; PG8_MMA(1, 0, At, B0); PG8_MMA(1, 1, At, B1); PG8_BAR; PG8_SCHED;
            } else {
            PG8_LDB(B0, 0, 0); PG8_SCHED; PG8_LDA(At, 0, 0); PG8_STAGE(PG8_SA(1, 1), a1 + hstep, voffA);
            PG8_WAIT_L(8); PG8_BAR; PG8_WAIT_L(0); PG8_MMA(0, 0, At, B0); PG8_BAR; PG8_SCHED;
            PG8_LDB(B1, 0, 1); PG8_STAGE(PG8_SB(0, 0), b2, voffB);
            PG8_BAR; PG8_WAIT_L(0); PG8_MMA(0, 1, At, B1); PG8_BAR;
            PG8_LDA(At, 0, 1); PG8_STAGE(PG8_SA(0, 0), a2, voffA);
            PG8_BAR; PG8_WAIT_L(0); PG8_MMA(1, 0, At, B0); PG8_BAR; PG8_SCHED;
            PG8_STAGE(PG8_SB(0, 1), b2 + hstep, voffB);
            PG8_WAIT_V(6); PG8_BAR; PG8_MMA(1, 1, At, B1); PG8_BAR;
            PG8_LDB(B0, 1, 0); PG8_SCHED; PG8_LDA(At, 1, 0); PG8_STAGE(PG8_SA(0, 1), a2 + hstep, voffA);
            PG8_WAIT_L(8); PG8_BAR; PG8_WAIT_L(0); PG8_MMA(0, 0, At, B0); PG8_BAR; PG8_SCHED;
            PG8_LDB(B1, 1, 1); PG8_STAGE(PG8_SB(1, 0), b3, voffB);
            PG8_BAR; PG8_WAIT_L(0); PG8_MMA(0, 1, At, B1); PG8_BAR;
            PG8_LDA(At, 1, 1); PG8_STAGE(PG8_SA(1, 0), a3, voffA);
            PG8_BAR; PG8_WAIT_L(0); PG8_MMA(1, 0, At, B0); PG8_BAR; PG8_SCHED;
            PG8_STAGE(PG8_SB(1, 1), b3 + hstep, voffB);
            PG8_WAIT_V(6); PG8_BAR; PG8_MMA(1, 1, At, B1); PG8_BAR;
            }
        }
        if constexpr (ALIGN_EPI) { if (wr == 0) PG8_BAR; }
        if constexpr (!Epi::AFTER_DRAIN) { E(acc, cur, wr, wc, fr, fq); S.done(cur); }
        if (!has_next) break;
#pragma unroll
        for (int a = 0; a < 2; ++a)
#pragma unroll
            for (int b = 0; b < 2; ++b)
#pragma unroll
                for (int m = 0; m < 4; ++m)
#pragma unroll
                    for (int n = 0; n < 2; ++n) acc[a][b][m][n] = (f32x4){0.f, 0.f, 0.f, 0.f};
        cur = nxt; cA = nA; cB = nB; ++ui;
        if constexpr (ALIGN_EPI) { if (wr == 1) PG8_BAR; }
    }
    PG8_WAIT_V(0);
    if constexpr (!ALIGN_EPI) { if (wr == 0) PG8_BAR; }
    PG8_BAR;
    if constexpr (Epi::AFTER_DRAIN) { E.fused(acc, cur, wr, wc, fr, fq, lds, wid, lane); S.done(cur); }
#undef PG8_SA
#undef PG8_SB
#undef PG8_STAGE
#undef PG8_LDA
#undef PG8_LDB
#undef PG8_MMA
#undef PG8_WAIT_V
#undef PG8_WAIT_L
#undef PG8_BAR
#undef PG8_SCHED
}
}
constexpr int NWAVES = 8;
constexpr int BATCH = 4, SEQ = 4096, DM = 4096, M = BATCH * SEQ;
constexpr int D_ATTN = 2048, D_KV = 256, D_SSM = 2048, D_IN = 4608, D_FF = 16384, NMODC = 6 * DM;
constexpr float EPS = 1e-6f, LOG2E = 1.4426950408889634f;
constexpr size_t MiB = 1u << 20;
constexpr size_t WS_CTL = 0, CTL_ZERO_BYTES = 2 * MiB;
constexpr size_t WS_MOD = 1 * MiB;
constexpr size_t WS_ROPE = 2 * MiB;
constexpr size_t WS_SSA = 4 * MiB, WS_SSS = 6 * MiB;
constexpr size_t WS_WIN = 8 * MiB, WS_WGLU = 44 * MiB, WS_WOUT = 52 * MiB, WS_WFF1 = 84 * MiB, WS_WFF2 = 212 * MiB;
constexpr size_t WS_H = 340 * MiB;
constexpr size_t WS_Q = 468 * MiB, WS_K = 532 * MiB, WS_V = 540 * MiB, WS_U = 548 * MiB;
constexpr size_t WS_MIX = 612 * MiB;
constexpr size_t WS_YG = 740 * MiB;
constexpr size_t WS_HID = 804 * MiB;
constexpr size_t WS_END = 1316 * MiB;
constexpr int CW_BAR = 4096;
constexpr int RING_OFF = 0, RING_BYTES = 131072;
constexpr int LDSCTL_OFF = RING_BYTES, MISC_OFF = LDSCTL_OFF + 320;
constexpr int LDS_BYTES = 147456;

#define GAS __attribute__((address_space(1)))
#define LAS __attribute__((address_space(3)))
typedef unsigned short bf16;
typedef unsigned v4u __attribute__((ext_vector_type(4)));
typedef float f32x4 __attribute__((ext_vector_type(4)));
typedef short bf16x8 __attribute__((ext_vector_type(8)));
typedef GAS unsigned gu32;
typedef GAS unsigned long long gu64;
#define RLX_AGENT __ATOMIC_RELAXED, __HIP_MEMORY_SCOPE_AGENT
#define LDS_WAIT() asm volatile("s_waitcnt lgkmcnt(0)" ::: "memory")
#define VM_WAIT() asm volatile("s_waitcnt vmcnt(0)" ::: "memory")
__device__ __forceinline__ unsigned long long rt() { return __builtin_amdgcn_s_memrealtime(); }
__device__ __forceinline__ unsigned f2bf(float f) { unsigned u = __builtin_bit_cast(unsigned, f); return (u + 0x7fffu + ((u >> 16) & 1u)) >> 16; }
__device__ __forceinline__ unsigned pk2(float lo, float hi) { return f2bf(lo) | (f2bf(hi) << 16); }

#define XB_TMO      128
#define XB_XCNT(j)  (256  + 64 * (j))
#define XB_XSUB(j)  (1280 + 64 * (j))
#define XB_XGEN(j)  (2304 + 64 * (j))
#define XB_TOP      3328
#define XB_TOPGEN   3392
#define XCD_BAR_WORDS 3456
#define XB_SPIN_CAP (1u << 21)

__device__ __forceinline__ unsigned xb_ld(unsigned* p)              { return __hip_atomic_load(p, __ATOMIC_RELAXED, __HIP_MEMORY_SCOPE_AGENT); }
__device__ __forceinline__ unsigned xb_add(unsigned* p, unsigned v) { return __hip_atomic_fetch_add(p, v, __ATOMIC_RELAXED, __HIP_MEMORY_SCOPE_AGENT); }
__device__ __forceinline__ unsigned xb_xcc_id() { return (unsigned)__builtin_amdgcn_s_getreg((3 << 11) | 20) & 0xFu; }
#define XB_SPIN(cond, bar) do { unsigned _sp = 0; while (cond) { __builtin_amdgcn_s_sleep(1); \
    if ((++_sp & 255u) == 0u) { if (xb_ld(&(bar)[XB_TMO])) break; if (_sp > XB_SPIN_CAP) { atomicAdd(&(bar)[XB_TMO], 1u); break; } } } } while (0)

struct XcdBarrier {
    unsigned* bar; unsigned x;
    volatile LAS unsigned* st;
};

__device__ __forceinline__ XcdBarrier xcd_barrier_post(unsigned* bar, volatile LAS unsigned* st) {
    XcdBarrier b; b.bar = bar; b.x = xb_xcc_id(); b.st = st;
    if (threadIdx.x == 0) (void)xb_add(&bar[XB_XCNT(b.x)], 1u);
    return b;
}
__device__ __forceinline__ void xcd_barrier_complete(unsigned* bar, unsigned x, unsigned& nloc, unsigned& nx) {
    const unsigned G = gridDim.x * gridDim.y * gridDim.z;
    unsigned sum, cnt, mine, sp = 0u;
    for (;;) {
        sum = 0u; cnt = 0u; mine = 0u;
#pragma unroll
        for (unsigned j = 0; j < 16; ++j) { const unsigned c = xb_ld(&bar[XB_XCNT(j)]); sum += c; cnt += (c > 0u) ? 1u : 0u; mine = (j == x) ? c : mine; }
        if (sum == G) break;
        __builtin_amdgcn_s_sleep(1);
        if ((++sp & 255u) == 0u) { if (xb_ld(&bar[XB_TMO])) break; if (sp > XB_SPIN_CAP) { atomicAdd(&bar[XB_TMO], 1u); break; } }
    }
    nloc = mine > 0u ? mine : 1u; nx = cnt > 0u ? cnt : 1u;
}

__device__ __forceinline__ void xcd_barrier(const XcdBarrier& b) {
    asm volatile("s_waitcnt vmcnt(0)" ::: "memory");
    __syncthreads();
    if (threadIdx.x == 0) {
        unsigned* bar = b.bar;
        __builtin_amdgcn_s_waitcnt(0);
        unsigned nloc = b.st[0], nx = b.st[1];
        if (nloc == 0u) { xcd_barrier_complete(bar, b.x, nloc, nx); b.st[0] = nloc; b.st[1] = nx; }
        const unsigned old = xb_add(&bar[XB_XSUB(b.x)], 1u);
        const unsigned gen = old / nloc;
        if (old + 1u == (gen + 1u) * nloc) {
            __builtin_amdgcn_fence(__ATOMIC_RELEASE, "agent");
            asm volatile("s_waitcnt vmcnt(0)" ::: "memory");
            const unsigned og = xb_add(&bar[XB_TOP], 1u);
            const unsigned tg = og / nx;
            if (og + 1u == (tg + 1u) * nx) xb_add(&bar[XB_TOPGEN], 1u);
            else XB_SPIN(xb_ld(&bar[XB_TOPGEN]) == tg, bar);
            __builtin_amdgcn_fence(__ATOMIC_ACQUIRE, "agent");
            xb_add(&bar[XB_XGEN(b.x)], 1u);
            asm volatile("s_waitcnt vmcnt(0)" ::: "memory");
        } else {
            XB_SPIN(xb_ld(&bar[XB_XGEN(b.x)]) == gen, bar);
            __builtin_amdgcn_fence(__ATOMIC_ACQUIRE, "agent");
            asm volatile("s_waitcnt vmcnt(0)" ::: "memory");
        }
    }
    __syncthreads();
}


struct Frame {
    LAS unsigned char* lds;
    volatile LAS unsigned* MISC;
    gu32* ctl;
    int tid, lane, wave;
    int vcu, G;
};
__device__ __forceinline__ float wave_sum(float v) {
#pragma unroll
    for (int o = 1; o < 64; o <<= 1) v += __shfl_xor(v, o);
    return v;
}
__device__ __forceinline__ float wave_max(float v) {
#pragma unroll
    for (int o = 1; o < 64; o <<= 1) v = fmaxf(v, __shfl_xor(v, o));
    return v;
}
__device__ __forceinline__ float bf2f(unsigned short h) { return __builtin_bit_cast(float, (unsigned)h << 16); }
__device__ __forceinline__ float bflo(unsigned w) { return __builtin_bit_cast(float, w << 16); }
__device__ __forceinline__ float bfhi(unsigned w) { return __builtin_bit_cast(float, w & 0xffff0000u); }
__device__ __forceinline__ void dsincos(double x, float& s, float& c) {
    const double k = __builtin_rint(x * 0.63661977236758134308);
    double r = __builtin_fma(-k, 1.57079632679489655800e+00, x); r = __builtin_fma(-k, 6.12323399573676603587e-17, r);
    const double r2 = r * r;
    double sp = -7.6471637318198164759e-13; sp = sp * r2 + 1.6059043836821614599e-10; sp = sp * r2 - 2.5052108385441718775e-08; sp = sp * r2 + 2.7557319223985890653e-06;
    sp = sp * r2 - 1.9841269841269841270e-04; sp = sp * r2 + 8.3333333333333333333e-03; sp = sp * r2 - 1.6666666666666666667e-01; sp = r + r * r2 * sp;
    double cp = 4.7794773323873852974e-14; cp = cp * r2 - 1.1470745597729724714e-11; cp = cp * r2 + 2.0876756987868098979e-09; cp = cp * r2 - 2.7557319223985890653e-07;
    cp = cp * r2 + 2.4801587301587301587e-05; cp = cp * r2 - 1.3888888888888888889e-03; cp = cp * r2 + 4.1666666666666666667e-02; cp = cp * r2 - 0.5; cp = 1.0 + r2 * cp;
    const int q = (int)((long long)k & 3);
    const double ss = (q & 1) ? cp : sp, cc = (q & 1) ? sp : cp;
    s = (float)((q & 2) ? -ss : ss); c = (float)(((q + 1) & 2) ? -cc : cc);
}

template <int MODE> __device__ __forceinline__ void p0_transpose_item(const float* W, int K, int N, bf16* WT, LAS float* scr, int item, int lane, const float* gk) {
    const int nblk = N / 32, kb = item / nblk, nb = item % nblk, k0 = 64 * kb, n0 = 32 * nb;
#pragma unroll 8
    for (int i = 0; i < 32; ++i) { const int kk = 2 * i + (lane >> 5); float w = W[(size_t)(k0 + kk) * N + n0 + (lane & 31)]; if (MODE == 2) w *= gk[k0 + kk]; scr[kk * 33 + (lane & 31)] = w; }
    LDS_WAIT(); asm volatile("" ::: "memory");
    const int c = lane & 7;
#pragma unroll
    for (int j = 0; j < 4; ++j) { const int n = (lane >> 3) + 8 * j; const LAS float* s = scr + (8 * c) * 33 + n;
        v4u o; o.x = pk2(s[0 * 33], s[1 * 33]); o.y = pk2(s[2 * 33], s[3 * 33]); o.z = pk2(s[4 * 33], s[5 * 33]); o.w = pk2(s[6 * 33], s[7 * 33]);
        int drow = n0 + n;
        if (MODE == 1 && drow < D_ATTN + D_KV) { const int d = drow & 63; drow = (drow & ~63) + 8 * ((d & 31) >> 2) + 4 * (d >> 5) + (d & 3); }
        *(GAS v4u*)(WT + (size_t)drow * K + k0 + 8 * c) = o; }
    LDS_WAIT(); asm volatile("" ::: "memory");
}
__device__ __forceinline__ void p0_gemv_item(const float* cvec, const float* w_ada, const float* b_ada, float* mod, int item, int lane) {
    const int nc = item % 96, kc = item / 96, n0 = nc * 256 + 4 * lane;
    f32x4 acc[4];
#pragma unroll
    for (int b = 0; b < 4; ++b) acc[b] = (f32x4){0.f, 0.f, 0.f, 0.f};
    for (int kh = 0; kh < 2; ++kh) { const int k0 = kc * 128 + kh * 64;
        float ca[4];
#pragma unroll
        for (int b = 0; b < 4; ++b) { const float cv = cvec[b * DM + k0 + lane]; ca[b] = cv / (1.0f + __expf(-cv)); }
        const GAS f32x4* wp = (const GAS f32x4*)(w_ada + (size_t)k0 * NMODC + n0);
#pragma unroll 8
        for (int kk = 0; kk < 64; ++kk) { const f32x4 w = wp[(size_t)kk * (NMODC / 4)];
#pragma unroll
            for (int b = 0; b < 4; ++b) { const float cb = __builtin_bit_cast(float, __builtin_amdgcn_readlane(__builtin_bit_cast(int, ca[b]), kk)); acc[b] += cb * w; } }
    }
    if (kc == 0) { const f32x4 bb = *(const GAS f32x4*)(b_ada + n0);
#pragma unroll
        for (int b = 0; b < 4; ++b) acc[b] += bb; }
#pragma unroll
    for (int b = 0; b < 4; ++b)
#pragma unroll
        for (int e = 0; e < 4; ++e) unsafeAtomicAdd(mod + b * NMODC + n0 + e, acc[b][e]);
}
struct In { const float *x, *c, *w_ada, *b_ada, *norm1_g, *w_in, *sinks, *lam_re, *lam_im, *log_step, *b_re, *b_im, *c_re, *c_im, *ssm_d, *w_glu, *b_glu, *attn_g, *ssm_g, *w_out, *norm2_g, *w_ff1, *w_ff2, *final_g; };
__device__ __forceinline__ void p0_prologue(Frame& F, const In& I, unsigned char* ws) {
    LAS float* scr = (LAS float*)(F.lds + RING_OFF + F.wave * 16384);
    const int gw = F.vcu * NWAVES + F.wave, NGW = F.G * NWAVES;
    float* mod = (float*)(ws + WS_MOD);
    for (int it = gw; it < 96 * 32; it += NGW) p0_gemv_item(I.c, I.w_ada, I.b_ada, mod, it, F.lane);
    constexpr int I_IN = (DM / 64) * (D_IN / 32), I_GLU = (D_SSM / 64) * (D_SSM / 32), I_OUT = (DM / 64) * (DM / 32), I_F1 = (DM / 64) * (D_FF / 32), I_F2 = (D_FF / 64) * (DM / 32);
    constexpr int NITEMS = I_IN + I_GLU + I_OUT + I_F1 + I_F2;
    bf16 *win = (bf16*)(ws + WS_WIN), *wglu = (bf16*)(ws + WS_WGLU), *wout = (bf16*)(ws + WS_WOUT), *wff1 = (bf16*)(ws + WS_WFF1), *wff2 = (bf16*)(ws + WS_WFF2);
    for (int it = gw; it < NITEMS; it += NGW) {
        int r = it;
        if (r < I_IN) { p0_transpose_item<1>(I.w_in, DM, D_IN, win, scr, r, F.lane, nullptr); continue; } r -= I_IN;
        if (r < I_GLU) { p0_transpose_item<0>(I.w_glu, D_SSM, D_SSM, wglu, scr, r, F.lane, nullptr); continue; } r -= I_GLU;
        if (r < I_OUT) { const int kb = r / (DM / 32); p0_transpose_item<2>(I.w_out, DM, DM, wout, scr, r, F.lane, kb < 32 ? I.attn_g : I.ssm_g - D_ATTN); continue; } r -= I_OUT;
        if (r < I_F1) { p0_transpose_item<0>(I.w_ff1, DM, D_FF, wff1, scr, r, F.lane, nullptr); continue; } r -= I_F1;
        p0_transpose_item<0>(I.w_ff2, D_FF, DM, wff2, scr, r, F.lane, nullptr);
    }
    float* rc = (float*)(ws + WS_ROPE); float* rs = rc + SEQ * 32;
    for (int idx = gw * 64 + F.lane; idx < SEQ * 32; idx += NGW * 64) { const int pos = idx >> 5, f = idx & 31;
        const float inv = exp2f(-(float)f * (13.287712379549449f / 32.0f)); const float ang = (float)pos * inv;
        float s, c; dsincos((double)ang, s, c); rc[idx] = c; rs[idx] = s; }
}
__device__ __forceinline__ void norm_mod_row(const float* xrow, const float* g, const float* scale, const float* shift, bf16* orow, int lane) {
    const GAS f32x4* xr = (const GAS f32x4*)xrow + lane;
    f32x4 v[16]; float s = 0.f;
#pragma unroll
    for (int j = 0; j < 16; ++j) { v[j] = xr[64 * j]; s += (v[j].x * v[j].x + v[j].y * v[j].y) + (v[j].z * v[j].z + v[j].w * v[j].w); }
    const float r = 1.0f / sqrtf(wave_sum(s) * (1.0f / DM) + EPS);
    GAS unsigned long long* o8 = (GAS unsigned long long*)orow + lane;
#pragma unroll
    for (int j = 0; j < 16; ++j) { const f32x4 gg = ((const GAS f32x4*)g)[64 * j + lane], sc = ((const GAS f32x4*)scale)[64 * j + lane], sh = ((const GAS f32x4*)shift)[64 * j + lane];
        const f32x4 o = (v[j] * r) * gg * (sc + 1.0f) + sh;
        o8[64 * j] = (unsigned long long)pk2(o.x, o.y) | ((unsigned long long)pk2(o.z, o.w) << 32); }
}
__device__ __forceinline__ void final_norm_row(float* xrow, const float* g, int lane) {
    GAS f32x4* xr = (GAS f32x4*)xrow + lane;
    f32x4 v[16]; float s = 0.f;
#pragma unroll
    for (int j = 0; j < 16; ++j) { v[j] = xr[64 * j]; s += (v[j].x * v[j].x + v[j].y * v[j].y) + (v[j].z * v[j].z + v[j].w * v[j].w); }
    const float r = 1.0f / sqrtf(wave_sum(s) * (1.0f / DM) + EPS);
#pragma unroll
    for (int j = 0; j < 16; ++j) { const f32x4 gg = ((const GAS f32x4*)g)[64 * j + lane]; xr[64 * j] = (v[j] * r) * gg; }
}
__device__ __forceinline__ void mix_scale_row(bf16* mrow, const float* ssa, const float* sss, int lane) {
    float p = lane < 32 ? ssa[lane] : sss[lane - 32];
#pragma unroll
    for (int o = 1; o < 32; o <<= 1) p += __shfl_xor(p, o);
    const float rmine = 1.0f / sqrtf(p * (1.0f / 2048.0f) + EPS), rother = __shfl_xor(rmine, 32);
    const float ra = lane < 32 ? rmine : rother, rs = lane < 32 ? rother : rmine;
    GAS v4u* mp = (GAS v4u*)mrow + lane;
#pragma unroll
    for (int j = 0; j < 8; ++j) { v4u w = mp[64 * j]; const float r = j < 4 ? ra : rs;
        w.x = pk2(bflo(w.x) * r, bfhi(w.x) * r); w.y = pk2(bflo(w.y) * r, bfhi(w.y) * r); w.z = pk2(bflo(w.z) * r, bfhi(w.z) * r); w.w = pk2(bflo(w.w) * r, bfhi(w.w) * r);
        mp[64 * j] = w; }
}

__device__ __forceinline__ void attn_phase_simple(Frame& F, const bf16* Q, const bf16* K, const bf16* V, bf16* O, float* SSA, const float* sinks) {
    LAS unsigned* Ks = (LAS unsigned*)(F.lds);
    LAS unsigned short* Vs = (LAS unsigned short*)(F.lds + 33792);
    LAS float* wsc = (LAS float*)(F.lds + 33792 + 32768 + F.wave * 1024);
    const int lane = F.lane;
    for (int unit = F.vcu; unit < BATCH * 32 * 4; unit += F.G) {
        const int kvh = unit & 3, nb = (unit >> 2) & 31, b = unit >> 7;
        const size_t tok0 = (size_t)b * SEQ + nb * 128;
        __syncthreads();
        for (int c = F.tid; c < 2048; c += NWAVES * 64) { const int kk = c >> 3, ch = c & 7;
            v4u kv = (v4u){0u, 0u, 0u, 0u}, vv = (v4u){0u, 0u, 0u, 0u};
            if (nb > 0 || kk >= 128) { const size_t r = tok0 - 128 + kk; kv = *(const GAS v4u*)(K + r * D_KV + kvh * 64 + ch * 8); vv = *(const GAS v4u*)(V + r * D_KV + kvh * 64 + ch * 8); }
            LAS unsigned* kd = Ks + kk * 33 + ch * 4; kd[0] = kv.x; kd[1] = kv.y; kd[2] = kv.z; kd[3] = kv.w;
            *(LAS v4u*)(Vs + kk * 64 + ch * 8) = vv; }
        __syncthreads();
        const int hq = kvh * 8 + F.wave; const float sink2 = sinks[hq] * LOG2E;
        for (int i = 0; i < 128; ++i) {
            const size_t row = tok0 + i;
            wsc[lane] = bf2f(Q[row * D_ATTN + hq * 64 + lane]);
            f32x4 q4[16];
#pragma unroll
            for (int j = 0; j < 16; ++j) q4[j] = *(const LAS f32x4*)(wsc + 4 * j);
            const int kA = i + 1 + lane, kB = kA + 64;
            float sA = 0.f, sB = 0.f;
#pragma unroll
            for (int j = 0; j < 16; ++j) { const unsigned a0 = Ks[kA * 33 + 2 * j], a1 = Ks[kA * 33 + 2 * j + 1], b0 = Ks[kB * 33 + 2 * j], b1 = Ks[kB * 33 + 2 * j + 1];
                sA += q4[j].x * bflo(a0) + q4[j].y * bfhi(a0) + q4[j].z * bflo(a1) + q4[j].w * bfhi(a1);
                sB += q4[j].x * bflo(b0) + q4[j].y * bfhi(b0) + q4[j].z * bflo(b1) + q4[j].w * bfhi(b1); }
            if (nb == 0) { if (kA < 128) sA = -INFINITY; if (kB < 128) sB = -INFINITY; }
            const float mx = fmaxf(wave_max(fmaxf(sA, sB)), sink2);
            const float pA = exp2f(sA - mx), pB = exp2f(sB - mx);
            const float den = wave_sum(pA + pB) + exp2f(sink2 - mx);
            wsc[64 + lane] = pA; wsc[128 + lane] = pB;
            float o = 0.f;
#pragma unroll 8
            for (int l4 = 0; l4 < 32; ++l4) { const f32x4 p4 = *(const LAS f32x4*)(wsc + 64 + 4 * l4); const LAS unsigned short* vp = Vs + (i + 1 + 4 * l4) * 64 + lane;
                o += p4.x * bf2f(vp[0]) + p4.y * bf2f(vp[64]) + p4.z * bf2f(vp[128]) + p4.w * bf2f(vp[192]); }
            o = o / den;
            const unsigned ob = f2bf(o); const float of = bf2f((unsigned short)ob);
            const float ss = wave_sum(of * of);
            O[row * DM + hq * 64 + lane] = (bf16)ob;
            if (lane == 0) SSA[row * 32 + hq] = ss;
        }
    }
}

__device__ __forceinline__ float erf_gelu(float y) { return 0.5f * y * (1.0f + erff(y * 0.70710678118654752f)); }
__device__ __forceinline__ void ssm_phase_simple(Frame& F, const In& I, const bf16* U, bf16* YG) {
    const int lane = F.lane, w = F.wave;
    LAS unsigned* ul = (LAS unsigned*)(F.lds + w * 4096);
    LAS unsigned short* yl = (LAS unsigned short*)(F.lds + w * 4096 + 2048);
    LAS float* E = (LAS float*)(F.lds + 32768);
    for (int unit = F.vcu; unit < BATCH * 128; unit += F.G) {
        const int b = unit >> 7, g = unit & 127, p = lane;
        const float step = expf(I.log_step[g]), lre = I.lam_re[g * 64 + p], lim = I.lam_im[g * 64 + p];
        float lr, li; { const float er = expf(lre * step); float s, c; dsincos((double)(lim * step), s, c); lr = er * c; li = er * s; }
        float cfr, cfi; { const float nr = lr - 1.0f, ni = li, den = lre * lre + lim * lim; cfr = (nr * lre + ni * lim) / den; cfi = (ni * lre - nr * lim) / den; }
        float bbr[16], bbi[16], cr[16], ci[16];
#pragma unroll
        for (int h4 = 0; h4 < 4; ++h4) { const f32x4 br = *(const GAS f32x4*)(I.b_re + (size_t)(g * 64 + p) * 16 + 4 * h4), bi = *(const GAS f32x4*)(I.b_im + (size_t)(g * 64 + p) * 16 + 4 * h4);
#pragma unroll
            for (int e = 0; e < 4; ++e) { bbr[4 * h4 + e] = cfr * br[e] - cfi * bi[e]; bbi[4 * h4 + e] = cfr * bi[e] + cfi * br[e]; } }
#pragma unroll
        for (int h = 0; h < 16; ++h) { cr[h] = I.c_re[(size_t)(g * 16 + h) * 64 + p]; ci[h] = I.c_im[(size_t)(g * 16 + h) * 64 + p]; }
        float l5r = lr, l5i = li;
#pragma unroll
        for (int k = 0; k < 9; ++k) { const float nr = l5r * l5r - l5i * l5i, ni = 2.0f * l5r * l5i; l5r = nr; l5i = ni; }
        const float dsk = I.ssm_d[g * 16 + (lane >> 2)];
        const size_t row0 = (size_t)b * SEQ + w * 512;
        __syncthreads();
        float sr = 0.f, si = 0.f;
        for (int c = 0; c < 8; ++c) {
            { const GAS v4u* up = (const GAS v4u*)(U + (row0 + c * 64 + lane) * D_SSM + g * 16); const v4u a = up[0], bq = up[1];
              *(LAS v4u*)(ul + lane * 8) = a; *(LAS v4u*)(ul + lane * 8 + 4) = bq; }
            for (int tt = 0; tt < 64; ++tt) { const v4u a = *(const LAS v4u*)(ul + tt * 8), bq = *(const LAS v4u*)(ul + tt * 8 + 4);
                const float uu[16] = {bflo(a.x), bfhi(a.x), bflo(a.y), bfhi(a.y), bflo(a.z), bfhi(a.z), bflo(a.w), bfhi(a.w), bflo(bq.x), bfhi(bq.x), bflo(bq.y), bfhi(bq.y), bflo(bq.z), bfhi(bq.z), bflo(bq.w), bfhi(bq.w)};
                float zr = 0.f, zi = 0.f;
#pragma unroll
                for (int h = 0; h < 16; ++h) { zr += bbr[h] * uu[h]; zi += bbi[h] * uu[h]; }
                const float nr = lr * sr - li * si + zr, ni = lr * si + li * sr + zi; sr = nr; si = ni; }
        }
        E[(w * 64 + lane) * 2] = sr; E[(w * 64 + lane) * 2 + 1] = si;
        __syncthreads();
        sr = 0.f; si = 0.f;
        for (int wp = 0; wp < w; ++wp) { const float er = E[(wp * 64 + lane) * 2], ei = E[(wp * 64 + lane) * 2 + 1];
            const float nr = l5r * sr - l5i * si + er, ni = l5r * si + l5i * sr + ei; sr = nr; si = ni; }
        for (int c = 0; c < 8; ++c) {
            { const GAS v4u* up = (const GAS v4u*)(U + (row0 + c * 64 + lane) * D_SSM + g * 16); const v4u a = up[0], bq = up[1];
              *(LAS v4u*)(ul + lane * 8) = a; *(LAS v4u*)(ul + lane * 8 + 4) = bq; }
            for (int tt = 0; tt < 64; ++tt) { const v4u a = *(const LAS v4u*)(ul + tt * 8), bq = *(const LAS v4u*)(ul + tt * 8 + 4);
                const float uu[16] = {bflo(a.x), bfhi(a.x), bflo(a.y), bfhi(a.y), bflo(a.z), bfhi(a.z), bflo(a.w), bfhi(a.w), bflo(bq.x), bfhi(bq.x), bflo(bq.y), bfhi(bq.y), bflo(bq.z), bfhi(bq.z), bflo(bq.w), bfhi(bq.w)};
                float zr = 0.f, zi = 0.f;
#pragma unroll
                for (int h = 0; h < 16; ++h) { zr += bbr[h] * uu[h]; zi += bbi[h] * uu[h]; }
                const float nr = lr * sr - li * si + zr, ni = lr * si + li * sr + zi; sr = nr; si = ni;
                float v[16];
#pragma unroll
                for (int h = 0; h < 16; ++h) v[h] = cr[h] * sr - ci[h] * si;
#pragma unroll
                for (int i = 0; i < 8; ++i) { const bool hi = lane & 32; const float keep = hi ? v[i + 8] : v[i], send = hi ? v[i] : v[i + 8]; v[i] = keep + __shfl_xor(send, 32); }
#pragma unroll
                for (int i = 0; i < 4; ++i) { const bool hi = lane & 16; const float keep = hi ? v[i + 4] : v[i], send = hi ? v[i] : v[i + 4]; v[i] = keep + __shfl_xor(send, 16); }
#pragma unroll
                for (int i = 0; i < 2; ++i) { const bool hi = lane & 8; const float keep = hi ? v[i + 2] : v[i], send = hi ? v[i] : v[i + 2]; v[i] = keep + __shfl_xor(send, 8); }
                { const bool hi = lane & 4; const float keep = hi ? v[1] : v[0], send = hi ? v[0] : v[1]; v[0] = keep + __shfl_xor(send, 4); }
                float y = v[0]; y += __shfl_xor(y, 2); y += __shfl_xor(y, 1);
                const LAS unsigned short* ul16 = (const LAS unsigned short*)ul;
                y += dsk * bf2f(ul16[tt * 16 + (lane >> 2)]);
                y = erf_gelu(y);
                if ((lane & 3) == 0) yl[tt * 16 + (lane >> 2)] = (unsigned short)f2bf(y);
            }
            { const v4u a = *(const LAS v4u*)(yl + lane * 16), bq = *(const LAS v4u*)(yl + lane * 16 + 8);
              GAS v4u* yp = (GAS v4u*)(YG + (row0 + c * 64 + lane) * D_SSM + g * 16); yp[0] = a; yp[1] = bq; }
        }
    }
}

struct Args { const float* in[24]; float* out; unsigned char* ws; };
__global__ void __launch_bounds__(NWAVES * 64, 2) hymba_fwd(Args args) {
    extern __shared__ __attribute__((aligned(16))) unsigned char lds[];
    Frame F;
    F.lds = (LAS unsigned char*)lds;
    F.MISC = (volatile LAS unsigned*)(F.lds + MISC_OFF);
    F.tid = threadIdx.x; F.lane = F.tid & 63; F.wave = __builtin_amdgcn_readfirstlane(F.tid >> 6);
    F.G = gridDim.x; { const int bx = blockIdx.x; F.vcu = (F.G % 8 == 0) ? (bx % 8) * (F.G / 8) + bx / 8 : bx; }
    unsigned char* ws = args.ws;
    F.ctl = (gu32*)(ws + WS_CTL);
    In I;
    I.x = args.in[0]; I.c = args.in[1]; I.w_ada = args.in[2]; I.b_ada = args.in[3]; I.norm1_g = args.in[4]; I.w_in = args.in[5]; I.sinks = args.in[6];
    I.lam_re = args.in[7]; I.lam_im = args.in[8]; I.log_step = args.in[9]; I.b_re = args.in[10]; I.b_im = args.in[11]; I.c_re = args.in[12]; I.c_im = args.in[13];
    I.ssm_d = args.in[14]; I.w_glu = args.in[15]; I.b_glu = args.in[16]; I.attn_g = args.in[17]; I.ssm_g = args.in[18]; I.w_out = args.in[19]; I.norm2_g = args.in[20];
    I.w_ff1 = args.in[21]; I.w_ff2 = args.in[22]; I.final_g = args.in[23];
    float* out = args.out;
    const float* mod = (const float*)(ws + WS_MOD);
    bf16 *Wi = (bf16*)(ws + WS_WIN), *Wg = (bf16*)(ws + WS_WGLU), *Wo = (bf16*)(ws + WS_WOUT), *W1 = (bf16*)(ws + WS_WFF1), *W2 = (bf16*)(ws + WS_WFF2);
    bf16 *H = (bf16*)(ws + WS_H), *Qb = (bf16*)(ws + WS_Q), *Kb = (bf16*)(ws + WS_K), *Vb = (bf16*)(ws + WS_V), *Ub = (bf16*)(ws + WS_U);
    bf16 *MIX = (bf16*)(ws + WS_MIX), *YG = (bf16*)(ws + WS_YG), *HID = (bf16*)(ws + WS_HID);
    float *SSA = (float*)(ws + WS_SSA), *SSS = (float*)(ws + WS_SSS);
    const float* rcos = (const float*)(ws + WS_ROPE); const float* rsin = rcos + SEQ * 32;
    for (int u = F.tid; u < (LDS_BYTES - LDSCTL_OFF) / 4; u += NWAVES * 64) ((LAS unsigned*)(F.lds + LDSCTL_OFF))[u] = 0u;
    __syncthreads();
    XcdBarrier bar = xcd_barrier_post((unsigned*)(F.ctl + CW_BAR), F.MISC + 8);
    const int gw = F.vcu * NWAVES + F.wave, NGW = F.G * NWAVES;

    p0_prologue(F, I, ws);
    xcd_barrier(bar);
    for (int m = gw; m < M; m += NGW) { const float* mb = mod + (size_t)(m >> 12) * NMODC; norm_mod_row(I.x + (size_t)m * DM, I.norm1_g, mb + DM, mb, H + (size_t)m * DM, F.lane); }
    xcd_barrier(bar);
    { pg8::Gemm g{H, Wi, M, D_IN, DM}; pg8::StaticOrder S; S.init(M, D_IN, F.G, (int)blockIdx.x);
      pg8::EpiIn E{Qb, Kb, Vb, Ub, rcos, rsin, 0.125f * LOG2E};
      pg8::gemm_phase<pg8::EpiIn, pg8::StaticOrder, true, true>(F.lds + RING_OFF, g, S, E); }
    xcd_barrier(bar);
    attn_phase_simple(F, Qb, Kb, Vb, MIX, SSA, I.sinks);
    ssm_phase_simple(F, I, Ub, YG);
    xcd_barrier(bar);
    { pg8::Gemm g{YG, Wg, M, D_SSM, D_SSM}; pg8::StaticOrder S; S.init(M, D_SSM, F.G, (int)blockIdx.x);
      pg8::EpiGlu E{YG, I.b_glu, MIX, SSS};
      pg8::gemm_phase<pg8::EpiGlu, pg8::StaticOrder, true, true>(F.lds + RING_OFF, g, S, E); }
    xcd_barrier(bar);
    for (int m = gw; m < M; m += NGW) mix_scale_row(MIX + (size_t)m * DM, SSA + (size_t)m * 32, SSS + (size_t)m * 32, F.lane);
    xcd_barrier(bar);
    { pg8::Gemm g{MIX, Wo, M, DM, DM}; pg8::StaticOrder S; S.init(M, DM, F.G, (int)blockIdx.x);
      pg8::EpiRes E{I.x, out, mod + 2 * DM};
      pg8::gemm_phase<pg8::EpiRes, pg8::StaticOrder, true, true>(F.lds + RING_OFF, g, S, E); }
    xcd_barrier(bar);
    for (int m = gw; m < M; m += NGW) { const float* mb = mod + (size_t)(m >> 12) * NMODC; norm_mod_row(out + (size_t)m * DM, I.norm2_g, mb + 4 * DM, mb + 3 * DM, H + (size_t)m * DM, F.lane); }
    xcd_barrier(bar);
    { pg8::Gemm g{H, W1, M, D_FF, DM}; pg8::StaticOrder S; S.init(M, D_FF, F.G, (int)blockIdx.x);
      pg8::EpiSqRelu E{HID, D_FF};
      pg8::gemm_phase<pg8::EpiSqRelu, pg8::StaticOrder, true, true>(F.lds + RING_OFF, g, S, E); }
    xcd_barrier(bar);
    { pg8::Gemm g{HID, W2, M, DM, D_FF}; pg8::StaticOrder S; S.init(M, DM, F.G, (int)blockIdx.x);
      pg8::EpiRes E{out, out, mod + 5 * DM};
      pg8::gemm_phase<pg8::EpiRes, pg8::StaticOrder, true, true>(F.lds + RING_OFF, g, S, E); }
    xcd_barrier(bar);
    for (int m = gw; m < M; m += NGW) final_norm_row(out + (size_t)m * DM, I.final_g, F.lane);
}

extern "C" void kernel_launch(void* const* d_in, const int* in_sizes, int n_in, void* d_out, int out_size, void* d_ws, size_t ws_size, hipStream_t stream) {
    static int grid = 0;
    if (grid == 0) {
        if (n_in != 24 || in_sizes[0] != M * DM || out_size != M * DM || ws_size < WS_END) { fprintf(stderr, "kernel_launch: unexpected shapes: n_in %d in0 %d out %d ws %zu (need %zu); nothing launched\n", n_in, n_in > 0 ? in_sizes[0] : -1, out_size, ws_size, (size_t)WS_END); grid = -1; return; }
        int dev = 0, cus = 0, per_cu = 0;
        if (hipGetDevice(&dev) != hipSuccess || hipDeviceGetAttribute(&cus, hipDeviceAttributeMultiprocessorCount, dev) != hipSuccess) { grid = -1; return; }
        if (hipFuncSetAttribute((const void*)hymba_fwd, hipFuncAttributeMaxDynamicSharedMemorySize, LDS_BYTES) != hipSuccess) { fprintf(stderr, "kernel_launch: hipFuncSetAttribute failed\n"); grid = -1; return; }
        if (hipOccupancyMaxActiveBlocksPerMultiprocessor(&per_cu, (const void*)hymba_fwd, NWAVES * 64, LDS_BYTES) != hipSuccess || per_cu < 1)
            fprintf(stderr, "kernel_launch: note: occupancy query reports %d workgroups per CU\n", per_cu);
        (void)hipGetLastError();
        grid = cus;
    }
    if (grid < 0) return;
    if (hipMemsetAsync((char*)d_ws + WS_CTL, 0, CTL_ZERO_BYTES, stream) != hipSuccess) return;
    Args a{};
    for (int i = 0; i < 24; ++i) a.in[i] = (const float*)d_in[i];
    a.out = (float*)d_out; a.ws = (unsigned char*)d_ws;
    hipLaunchKernelGGL(hymba_fwd, dim3(grid), dim3(NWAVES * 64), LDS_BYTES, stream, a);
}
```

```cpp
#include <hip/hip_runtime.h>
#include <cstdio>
#include <cstdint>
namespace pg8 {
#define PG8_LAS __attribute__((address_space(3)))
typedef unsigned short bf16_t;
typedef short bf16x8 __attribute__((ext_vector_type(8)));
typedef float f32x4 __attribute__((ext_vector_type(4)));
typedef unsigned u32x4 __attribute__((ext_vector_type(4)));
constexpr int BM = 256, BK = 64, HALF = 128, HTB = HALF * BK * 2  , STAGE_BYTES = 8 * HTB, NXCD = 8, WGM = 8;

__host__ __device__ __forceinline__ int lds_byte(int r, int c) { const int st = (r >> 4) * 2 + (c >> 5), rr = r & 15, cc = c & 31, ob = rr * 64 + cc * 2; return st * 1024 + (ob ^ (((ob >> 9) & 1) << 5)); }
__host__ __device__ __forceinline__ void stage_rc(int b, int& R, int& C) { const int st = b / 1024, sb = b % 1024, swz = sb ^ (((sb >> 9) & 1) << 5); R = (st >> 1) * 16 + swz / 64; C = (st & 1) * 32 + (swz % 64) / 2; }
__host__ __device__ __forceinline__ int perm32(int rho) { const int n = rho >> 4, i = rho & 15; return 8 * (i >> 2) + 4 * n + (i & 3); }

struct Unit { int pm, pn; };
struct Gemm { const bf16_t* A; const bf16_t* Bt; int M, N, K; };

struct StaticOrder {
    int nM, nN, nwg, G, c;
    __host__ __device__ void init(int M, int N, int G_, int c_) { nM = M / BM; nN = N / BM; nwg = nM * nN; G = G_; c = c_; }
    __host__ __device__ bool next(int i, Unit& u) const {
        const long L = (long)i * G + c; if (L >= nwg) return false;
        int wgid = (int)L; { const int q = nwg / NXCD, r = nwg % NXCD, xcd = wgid % NXCD, off = wgid / NXCD; wgid = (xcd < r ? xcd * (q + 1) : r * (q + 1) + (xcd - r) * q) + off; }
        const int nig = WGM * nN, gid = wgid / nig, fm = gid * WGM, gsz = (nM - fm) < WGM ? (nM - fm) : WGM;
        u.pm = fm + ((wgid % nig) % gsz); u.pn = (wgid % nig) / gsz; return true;
    }
    __device__ __forceinline__ void a_ready(const Unit&) const {}
    __device__ __forceinline__ void done(const Unit&) const {}
};

__device__ __forceinline__ unsigned cvt_pk_bf16(float lo, float hi) { unsigned r; asm volatile("v_cvt_pk_bf16_f32 %0, %1, %2" : "=v"(r) : "v"(lo), "v"(hi)); return r; }
typedef float f32x2 __attribute__((ext_vector_type(2)));
__device__ __forceinline__ f32x2 gelu_pk(f32x2 v) {
    const f32x2 av = __builtin_elementwise_abs(v), d = av * 0.2316418882f + 1.0f;
    f32x2 t; t.x = __builtin_amdgcn_rcpf(d.x); t.y = __builtin_amdgcn_rcpf(d.y);
    f32x2 q = t * 0.5307027145f + (-0.7265760135f); q = q * t + 0.7107068705f; q = q * t + (-0.142248368f); q = q * t + 0.127414796f; q = q * t;
    const f32x2 s = (v * v) * (-0.72134752044f);
    f32x2 e; e.x = __builtin_amdgcn_exp2f(s.x); e.y = __builtin_amdgcn_exp2f(s.y);
    const f32x2 m = v * (q * e), r = v - m;
    f32x2 o; o.x = v.x < 0.f ? m.x : r.x; o.y = v.y < 0.f ? m.y : r.y; return o;
}

typedef unsigned u32x2 __attribute__((ext_vector_type(2)));
struct EpiIn {
    static constexpr bool PERM = true, AFTER_DRAIN = false;
    bf16_t *Q, *K, *V, *U; const float* rcos; const float* rsin; float qscale;
    __device__ __forceinline__ void operator()(const f32x4 (&acc)[2][2][4][2], const Unit& u, int wr, int wc, int fr, int fq) const {
        const int row0 = u.pm * BM + wr * 64 + fr, tile = u.pn, cw = wc * 32 + 8 * fq;
        if (tile < 9) {
            bf16_t* dst = tile < 8 ? Q + tile * 256 : K; const int ldc = tile < 8 ? 2048 : 256; const float sc = tile < 8 ? qscale : 1.0f;
            const int f0 = 4 * (4 * (wc & 1) + fq);
#pragma unroll
            for (int ai = 0; ai < 2; ++ai)
#pragma unroll
                for (int m = 0; m < 4; ++m) { const int row = row0 + ai * HALF + m * 16, pos = row & 4095;
                    const f32x4 cs = *(const f32x4*)(rcos + pos * 32 + f0) * sc, sn = *(const f32x4*)(rsin + pos * 32 + f0) * sc;
                    bf16_t* rowp = dst + (size_t)row * ldc + cw;
#pragma unroll
                    for (int bj = 0; bj < 2; ++bj) { const f32x4 x1 = acc[ai][bj][m][0], x2 = acc[ai][bj][m][1];
                        const f32x4 o1 = x1 * cs - x2 * sn, o2 = x2 * cs + x1 * sn;
                        u32x4 w; w.x = cvt_pk_bf16(o1[0], o1[1]); w.y = cvt_pk_bf16(o1[2], o1[3]); w.z = cvt_pk_bf16(o2[0], o2[1]); w.w = cvt_pk_bf16(o2[2], o2[3]);
                        *(u32x4*)(rowp + bj * HALF) = w; } }
        } else {
            bf16_t* dst = tile == 9 ? V : U + (tile - 10) * 256; const int ldc = tile == 9 ? 256 : 2048;
#pragma unroll
            for (int ai = 0; ai < 2; ++ai)
#pragma unroll
                for (int m = 0; m < 4; ++m) { bf16_t* rowp = dst + (size_t)(row0 + ai * HALF + m * 16) * ldc + cw;
#pragma unroll
                    for (int bj = 0; bj < 2; ++bj) { const f32x4 v0 = acc[ai][bj][m][0], v1 = acc[ai][bj][m][1];
                        u32x4 w; w.x = cvt_pk_bf16(v0[0], v0[1]); w.y = cvt_pk_bf16(v0[2], v0[3]); w.z = cvt_pk_bf16(v1[0], v1[1]); w.w = cvt_pk_bf16(v1[2], v1[3]);
                        *(u32x4*)(rowp + bj * HALF) = w; } }
        }
    }
};
__device__ __forceinline__ float bf_lo(unsigned w) { return __builtin_bit_cast(float, w << 16); }
__device__ __forceinline__ float bf_hi(unsigned w) { return __builtin_bit_cast(float, w & 0xffff0000u); }
struct EpiGlu {
    static constexpr bool PERM = true, AFTER_DRAIN = false;
    const bf16_t* YG; const float* bias; bf16_t* O; float* SS;
    __device__ __forceinline__ void operator()(const f32x4 (&acc)[2][2][4][2], const Unit& u, int wr, int wc, int fr, int fq) const {
        const int row0 = u.pm * BM + wr * 64 + fr, col0 = u.pn * BM + wc * 32 + 8 * fq;
        f32x4 bv[2][2];
#pragma unroll
        for (int bj = 0; bj < 2; ++bj)
#pragma unroll
            for (int n = 0; n < 2; ++n) bv[bj][n] = *(const f32x4*)(bias + col0 + bj * HALF + 4 * n);
#pragma unroll
        for (int ai = 0; ai < 2; ++ai)
#pragma unroll
            for (int m = 0; m < 4; ++m) { const int row = row0 + ai * HALF + m * 16; float ss = 0.f;
#pragma unroll
                for (int bj = 0; bj < 2; ++bj) { const u32x4 yw = *(const u32x4*)(YG + (size_t)row * 2048 + col0 + bj * HALF);
                    const f32x4 z0 = acc[ai][bj][m][0] + bv[bj][0], z1 = acc[ai][bj][m][1] + bv[bj][1];
                    float o[8]; const float y[8] = {bf_lo(yw.x), bf_hi(yw.x), bf_lo(yw.y), bf_hi(yw.y), bf_lo(yw.z), bf_hi(yw.z), bf_lo(yw.w), bf_hi(yw.w)};
#pragma unroll
                    for (int e = 0; e < 4; ++e) { o[e] = y[e] * __builtin_amdgcn_rcpf(1.0f + __builtin_amdgcn_exp2f(-1.4426950408889634f * z0[e]));
                                                  o[4 + e] = y[4 + e] * __builtin_amdgcn_rcpf(1.0f + __builtin_amdgcn_exp2f(-1.4426950408889634f * z1[e])); }
#pragma unroll
                    for (int e = 0; e < 8; ++e) ss += o[e] * o[e];
                    u32x4 w; w.x = cvt_pk_bf16(o[0], o[1]); w.y = cvt_pk_bf16(o[2], o[3]); w.z = cvt_pk_bf16(o[4], o[5]); w.w = cvt_pk_bf16(o[6], o[7]);
                    *(u32x4*)(O + (size_t)row * 4096 + 2048 + col0 + bj * HALF) = w; }
                ss += __shfl_xor(ss, 16); ss += __shfl_xor(ss, 32);
                if (fq == 0) SS[(size_t)row * 32 + u.pn * 4 + wc] = ss; }
    }
};
struct EpiRes {
    static constexpr bool PERM = false, AFTER_DRAIN = false;
    const float* base; float* out; const float* gate;
    __device__ __forceinline__ void operator()(const f32x4 (&acc)[2][2][4][2], const Unit& u, int wr, int wc, int fr, int fq) const {
        const int row0 = u.pm * BM + wr * 64 + fr, col0 = u.pn * BM + wc * 32 + 4 * fq; const float* gp = gate + (size_t)((u.pm * BM) >> 12) * 24576 + col0;
        f32x4 gv[2][2];
#pragma unroll
        for (int bj = 0; bj < 2; ++bj)
#pragma unroll
            for (int n = 0; n < 2; ++n) gv[bj][n] = *(const f32x4*)(gp + bj * HALF + n * 16);
#pragma unroll
        for (int ai = 0; ai < 2; ++ai)
#pragma unroll
            for (int m = 0; m < 4; ++m) { const size_t off = (size_t)(row0 + ai * HALF + m * 16) * 4096 + col0;
#pragma unroll
                for (int bj = 0; bj < 2; ++bj)
#pragma unroll
                    for (int n = 0; n < 2; ++n) { const f32x4 b = *(const f32x4*)(base + off + bj * HALF + n * 16); *(f32x4*)(out + off + bj * HALF + n * 16) = b + gv[bj][n] * acc[ai][bj][m][n]; } }
    }
};
struct EpiSqRelu {
    static constexpr bool PERM = true, AFTER_DRAIN = false;
    bf16_t* O; int ldc;
    __device__ __forceinline__ void operator()(const f32x4 (&acc)[2][2][4][2], const Unit& u, int wr, int wc, int fr, int fq) const {
        const int row0 = u.pm * BM + wr * 64 + fr, col0 = u.pn * BM + wc * 32 + 8 * fq;
#pragma unroll
        for (int ai = 0; ai < 2; ++ai)
#pragma unroll
            for (int m = 0; m < 4; ++m) { bf16_t* rowp = O + (size_t)(row0 + ai * HALF + m * 16) * ldc + col0;
#pragma unroll
                for (int bj = 0; bj < 2; ++bj) { f32x4 v0 = acc[ai][bj][m][0], v1 = acc[ai][bj][m][1];
#pragma unroll
                    for (int e = 0; e < 4; ++e) { const float a = fmaxf(v0[e], 0.f), b = fmaxf(v1[e], 0.f); v0[e] = a * a; v1[e] = b * b; }
                    u32x4 w; w.x = cvt_pk_bf16(v0[0], v0[1]); w.y = cvt_pk_bf16(v0[2], v0[3]); w.z = cvt_pk_bf16(v1[0], v1[1]); w.w = cvt_pk_bf16(v1[2], v1[3]);
                    *(u32x4*)(rowp + bj * HALF) = w; } }
    }
};

template <class Epi, class Sched, bool ALIGN_EPI = false, bool SP2 = false>
__device__ __forceinline__ void gemm_phase(PG8_LAS unsigned char* lds, const Gemm g, const Sched& S, const Epi& E) {
    const int tid = threadIdx.x, wid = __builtin_amdgcn_readfirstlane(tid >> 6), lane = tid & 63, wr = wid >> 2, wc = wid & 3, fr = lane & 15, fq = lane >> 4;
    const int K = g.K, nt = K / BK;
    unsigned voffA[2], voffB[2];
#pragma unroll
    for (int i = 0; i < 2; ++i) { int R, C; stage_rc(tid * 16 + i * 8192, R, C); const int Rb = Epi::PERM ? ((R & ~31) + perm32(R & 31)) : R;
        voffA[i] = (unsigned)(R * K + C) * 2u; voffB[i] = (unsigned)(Rb * K + C) * 2u; }
    const size_t kstep = (size_t)(BK * 2);
    const size_t hstep = (size_t)HALF * K * 2;
    const size_t tstep = 2 * hstep;
    const unsigned ldsw = (unsigned)wid * 1024u;
    const int aoff = lds_byte(wr * 64 + fr, fq * 8), boff = lds_byte(wc * 32 + fr, fq * 8);
#define PG8_SA(b, h) (((b) * 2 + (h)) * HTB)
#define PG8_SB(b, h) ((4 + (b) * 2 + (h)) * HTB)
#define PG8_STAGE(bufoff, gbase, voff) do { _Pragma("unroll") for (int _i = 0; _i < 2; ++_i) \
        __builtin_amdgcn_global_load_lds((const unsigned*)((const char*)(gbase) + (voff)[_i]), (PG8_LAS unsigned*)(lds + (bufoff) + ldsw + _i * 8192), 16, 0, 0); } while (0)
#define PG8_LDA(dst, b, h) do { _Pragma("unroll") for (int m = 0; m < 4; ++m) _Pragma("unroll") for (int k = 0; k < 2; ++k) dst[m][k] = *(const PG8_LAS bf16x8*)(lds + PG8_SA(b, h) + aoff + m * 2048 + k * 1024); } while (0)
#define PG8_LDB(dst, b, h) do { _Pragma("unroll") for (int n = 0; n < 2; ++n) _Pragma("unroll") for (int k = 0; k < 2; ++k) dst[n][k] = *(const PG8_LAS bf16x8*)(lds + PG8_SB(b, h) + boff + n * 2048 + k * 1024); } while (0)
#define PG8_MMA(ai, bj, At, Bt) do { __builtin_amdgcn_s_setprio(1); _Pragma("unroll") for (int m = 0; m < 4; ++m) _Pragma("unroll") for (int n = 0; n < 2; ++n) _Pragma("unroll") for (int k = 0; k < 2; ++k) \
        acc[ai][bj][m][n] = __builtin_amdgcn_mfma_f32_16x16x32_bf16(Bt[n][k], At[m][k], acc[ai][bj][m][n], 0, 0, 0); __builtin_amdgcn_s_setprio(0); } while (0)
#define PG8_WAIT_V(n) asm volatile("s_waitcnt vmcnt(" #n ")" ::: "memory")
#define PG8_WAIT_L(n) asm volatile("s_waitcnt lgkmcnt(" #n ")" ::: "memory")
#define PG8_BAR __builtin_amdgcn_s_barrier()
#define PG8_SCHED __builtin_amdgcn_sched_barrier(0)
    Unit cur, nxt; int ui = 0;
    if (!S.next(0, cur)) return;
    f32x4 acc[2][2][4][2];
#pragma unroll
    for (int a = 0; a < 2; ++a)
#pragma unroll
        for (int b = 0; b < 2; ++b)
#pragma unroll
            for (int m = 0; m < 4; ++m)
#pragma unroll
                for (int n = 0; n < 2; ++n) acc[a][b][m][n] = (f32x4){0.f, 0.f, 0.f, 0.f};
    bf16x8 At[4][2], B0[2][2], B1[2][2];
    const char* cA = (const char*)g.A + (size_t)cur.pm * tstep; const char* cB = (const char*)g.Bt + (size_t)cur.pn * tstep;
    S.a_ready(cur);
    if constexpr (SP2) {
        PG8_STAGE(PG8_SB(0, 0), cB, voffB); PG8_STAGE(PG8_SB(0, 1), cB + hstep, voffB); PG8_STAGE(PG8_SA(0, 0), cA, voffA); PG8_STAGE(PG8_SA(0, 1), cA + hstep, voffA);
        if (wr == 1) PG8_BAR;
        PG8_WAIT_V(2); PG8_BAR;
        PG8_STAGE(PG8_SB(1, 0), cB + kstep, voffB); PG8_STAGE(PG8_SA(1, 0), cA + kstep, voffA); PG8_STAGE(PG8_SB(1, 1), cB + hstep + kstep, voffB);
        PG8_WAIT_V(6); PG8_BAR;
    } else {
        PG8_STAGE(PG8_SB(0, 0), cB, voffB); PG8_STAGE(PG8_SA(0, 0), cA, voffA); PG8_STAGE(PG8_SB(0, 1), cB + hstep, voffB); PG8_STAGE(PG8_SA(0, 1), cA + hstep, voffA);
        if (wr == 1) PG8_BAR;
        PG8_WAIT_V(4); PG8_BAR;
        PG8_STAGE(PG8_SB(1, 0), cB + kstep, voffB); PG8_STAGE(PG8_SA(1, 0), cA + kstep, voffA); PG8_STAGE(PG8_SB(1, 1), cB + hstep + kstep, voffB);
        PG8_WAIT_V(6); PG8_BAR;
    }
    for (;;) {
        const bool has_next = S.next(ui + 1, nxt);
        const char* nA = has_next ? (const char*)g.A + (size_t)nxt.pm * tstep : cA; const char* nB = has_next ? (const char*)g.Bt + (size_t)nxt.pn * tstep : cB;
        for (int t = 0; t < nt; t += 2) {
            const bool last = (t == nt - 2);
            const char* a1 = cA + (size_t)(t + 1) * kstep;
            const char* a2 = last ? nA : cA + (size_t)(t + 2) * kstep; const char* b2 = last ? nB : cB + (size_t)(t + 2) * kstep;
            const char* a3 = a2 + kstep; const char* b3 = b2 + kstep;
            if (last && has_next) S.a_ready(nxt);
            if constexpr (SP2) {
            PG8_LDB(B0, 0, 0); PG8_LDB(B1, 0, 1); PG8_SCHED; PG8_LDA(At, 0, 0); PG8_STAGE(PG8_SA(1, 1), a1 + hstep, voffA);
            PG8_WAIT_V(8); PG8_WAIT_L(0); PG8_BAR; PG8_MMA(0, 0, At, B0); PG8_MMA(0, 1, At, B1); PG8_BAR; PG8_SCHED;
            PG8_LDA(At, 0, 1); PG8_STAGE(PG8_SB(0, 0), b2, voffB); PG8_STAGE(PG8_SB(0, 1), b2 + hstep, voffB); PG8_STAGE(PG8_SA(0, 0), a2, voffA);
            PG8_WAIT_V(8); PG8_WAIT_L(0); PG8_BAR; PG8_MMA(1, 0, At, B0); PG8_MMA(1, 1, At, B1); PG8_BAR; PG8_SCHED;
            PG8_LDB(B0, 1, 0); PG8_LDB(B1, 1, 1); PG8_SCHED; PG8_LDA(At, 1, 0); PG8_STAGE(PG8_SA(0, 1), a2 + hstep, voffA);
            PG8_WAIT_V(8); PG8_WAIT_L(0); PG8_BAR; PG8_MMA(0, 0, At, B0); PG8_MMA(0, 1, At, B1); PG8_BAR; PG8_SCHED;
            PG8_LDA(At, 1, 1); PG8_STAGE(PG8_SB(1, 0), b3, voffB); PG8_STAGE(PG8_SB(1, 1), b3 + hstep, voffB); PG8_STAGE(PG8_SA(1, 0), a3, voffA);
            PG8_WAIT_V(8); PG8_WAIT_L(0); PG8_BAR; PG8_MMA(1, 0, At, B0); PG8_MMA(1, 1, At, B1); PG8_BAR; PG8_SCHED;
            } else {
            PG8_LDB(B0, 0, 0); PG8_SCHED; PG8_LDA(At, 0, 0); PG8_STAGE(PG8_SA(1, 1), a1 + hstep, voffA);
            PG8_WAIT_L(8); PG8_BAR; PG8_WAIT_L(0); PG8_MMA(0, 0, At, B0); PG8_BAR; PG8_SCHED;
            PG8_LDB(B1, 0, 1); PG8_STAGE(PG8_SB(0, 0), b2, voffB);
            PG8_BAR; PG8_WAIT_L(0); PG8_MMA(0, 1, At, B1); PG8_BAR;
            PG8_LDA(At, 0, 1); PG8_STAGE(PG8_SA(0, 0), a2, voffA);
            PG8_BAR; PG8_WAIT_L(0); PG8_MMA(1, 0, At, B0); PG8_BAR; PG8_SCHED;
            PG8_STAGE(PG8_SB(0, 1), b2 + hstep, voffB);
            PG8_WAIT_V(6); PG8_BAR; PG8_MMA(1, 1, At, B1); PG8_BAR;
            PG8_LDB(B0, 1, 0); PG8_SCHED; PG8_LDA(At, 1, 0); PG8_STAGE(PG8_SA(0, 1), a2 + hstep, voffA);
            PG8_WAIT_L(8); PG8_BAR; PG8_WAIT_L(0); PG8_MMA(0, 0, At, B0); PG8_BAR; PG8_SCHED;
            PG8_LDB(B1, 1, 1); PG8_STAGE(PG8_SB(1, 0), b3, voffB);
            PG8_BAR; PG8_WAIT_L(0); PG8_MMA(0, 1, At, B1); PG8_BAR;
            PG8_LDA(At, 1, 1); PG8_STAGE(PG8_SA(1, 0), a3, voffA);
            PG8_BAR; PG8_WAIT_L(0); PG8_MMA(1, 0, At, B0); PG8_BAR; PG8_SCHED;
            PG8_STAGE(PG8_SB(1, 1), b3 + hstep, voffB);
            PG8_WAIT_V(6); PG8_BAR; PG8_MMA(1, 1, At, B1); PG8_BAR;
            }
        }
        if constexpr (ALIGN_EPI) { if (wr == 0) PG8_BAR; }
        if constexpr (!Epi::AFTER_DRAIN) { E(acc, cur, wr, wc, fr, fq); S.done(cur); }
        if (!has_next) break;
#pragma unroll
        for (int a = 0; a < 2; ++a)
#pragma unroll
            for (int b = 0; b < 2; ++b)
#pragma unroll
                for (int m = 0; m < 4; ++m)
#pragma unroll
                    for (int n = 0; n < 2; ++n) acc[a][b][m][n] = (f32x4){0.f, 0.f, 0.f, 0.f};
        cur = nxt; cA = nA; cB = nB; ++ui;
        if constexpr (ALIGN_EPI) { if (wr == 1) PG8_BAR; }
    }
    PG8_WAIT_V(0);
    if constexpr (!ALIGN_EPI) { if (wr == 0) PG8_BAR; }
    PG8_BAR;
    if constexpr (Epi::AFTER_DRAIN) { E.fused(acc, cur, wr, wc, fr, fq, lds, wid, lane); S.done(cur); }
#undef PG8_SA
#undef PG8_SB
#undef PG8_STAGE
#undef PG8_LDA
#undef PG8_LDB
#undef PG8_MMA
#undef PG8_WAIT_V
#undef PG8_WAIT_L
#undef PG8_BAR
#undef PG8_SCHED
}
}
constexpr int NWAVES = 8;
constexpr int BATCH = 4, SEQ = 4096, DM = 4096, M = BATCH * SEQ;
constexpr int D_ATTN = 2048, D_KV = 256, D_SSM = 2048, D_IN = 4608, D_FF = 16384, NMODC = 6 * DM;
constexpr float EPS = 1e-6f, LOG2E = 1.4426950408889634f;
constexpr size_t MiB = 1u << 20;
constexpr size_t WS_CTL = 0, CTL_ZERO_BYTES = 2 * MiB;
constexpr size_t WS_MOD = 1 * MiB;
constexpr size_t WS_ROPE = 2 * MiB;
constexpr size_t WS_SSA = 4 * MiB, WS_SSS = 6 * MiB;
constexpr size_t WS_WIN = 8 * MiB, WS_WGLU = 44 * MiB, WS_WOUT = 52 * MiB, WS_WFF1 = 84 * MiB, WS_WFF2 = 212 * MiB;
constexpr size_t WS_H = 340 * MiB;
constexpr size_t WS_Q = 468 * MiB, WS_K = 532 * MiB, WS_V = 540 * MiB, WS_U = 548 * MiB;
constexpr size_t WS_MIX = 612 * MiB;
constexpr size_t WS_YG = 740 * MiB;
constexpr size_t WS_HID = 804 * MiB;
constexpr size_t WS_END = 1316 * MiB;
constexpr int CW_BAR = 4096;
constexpr int RING_OFF = 0, RING_BYTES = 131072;
constexpr int LDSCTL_OFF = RING_BYTES, MISC_OFF = LDSCTL_OFF + 320;
constexpr int LDS_BYTES = 147456;

#define GAS __attribute__((address_space(1)))
#define LAS __attribute__((address_space(3)))
typedef unsigned short bf16;
typedef unsigned v4u __attribute__((ext_vector_type(4)));
typedef float f32x4 __attribute__((ext_vector_type(4)));
typedef short bf16x8 __attribute__((ext_vector_type(8)));
typedef GAS unsigned gu32;
typedef GAS unsigned long long gu64;
#define RLX_AGENT __ATOMIC_RELAXED, __HIP_MEMORY_SCOPE_AGENT
#define LDS_WAIT() asm volatile("s_waitcnt lgkmcnt(0)" ::: "memory")
#define VM_WAIT() asm volatile("s_waitcnt vmcnt(0)" ::: "memory")
__device__ __forceinline__ unsigned long long rt() { return __builtin_amdgcn_s_memrealtime(); }
__device__ __forceinline__ unsigned f2bf(float f) { unsigned u = __builtin_bit_cast(unsigned, f); return (u + 0x7fffu + ((u >> 16) & 1u)) >> 16; }
__device__ __forceinline__ unsigned pk2(float lo, float hi) { return f2bf(lo) | (f2bf(hi) << 16); }

#define XB_TMO      128
#define XB_XCNT(j)  (256  + 64 * (j))
#define XB_XSUB(j)  (1280 + 64 * (j))
#define XB_XGEN(j)  (2304 + 64 * (j))
#define XB_TOP      3328
#define XB_TOPGEN   3392
#define XCD_BAR_WORDS 3456
#define XB_SPIN_CAP (1u << 21)

__device__ __forceinline__ unsigned xb_ld(unsigned* p)              { return __hip_atomic_load(p, __ATOMIC_RELAXED, __HIP_MEMORY_SCOPE_AGENT); }
__device__ __forceinline__ unsigned xb_add(unsigned* p, unsigned v) { return __hip_atomic_fetch_add(p, v, __ATOMIC_RELAXED, __HIP_MEMORY_SCOPE_AGENT); }
__device__ __forceinline__ unsigned xb_xcc_id() { return (unsigned)__builtin_amdgcn_s_getreg((3 << 11) | 20) & 0xFu; }
#define XB_SPIN(cond, bar) do { unsigned _sp = 0; while (cond) { __builtin_amdgcn_s_sleep(1); \
    if ((++_sp & 255u) == 0u) { if (xb_ld(&(bar)[XB_TMO])) break; if (_sp > XB_SPIN_CAP) { atomicAdd(&(bar)[XB_TMO], 1u); break; } } } } while (0)

struct XcdBarrier {
    unsigned* bar; unsigned x;
    volatile LAS unsigned* st;
};

__device__ __forceinline__ XcdBarrier xcd_barrier_post(unsigned* bar, volatile LAS unsigned* st) {
    XcdBarrier b; b.bar = bar; b.x = xb_xcc_id(); b.st = st;
    if (threadIdx.x == 0) (void)xb_add(&bar[XB_XCNT(b.x)], 1u);
    return b;
}
__device__ __forceinline__ void xcd_barrier_complete(unsigned* bar, unsigned x, unsigned& nloc, unsigned& nx) {
    const unsigned G = gridDim.x * gridDim.y * gridDim.z;
    unsigned sum, cnt, mine, sp = 0u;
    for (;;) {
        sum = 0u; cnt = 0u; mine = 0u;
#pragma unroll
        for (unsigned j = 0; j < 16; ++j) { const unsigned c = xb_ld(&bar[XB_XCNT(j)]); sum += c; cnt += (c > 0u) ? 1u : 0u; mine = (j == x) ? c : mine; }
        if (sum == G) break;
        __builtin_amdgcn_s_sleep(1);
        if ((++sp & 255u) == 0u) { if (xb_ld(&bar[XB_TMO])) break; if (sp > XB_SPIN_CAP) { atomicAdd(&bar[XB_TMO], 1u); break; } }
    }
    nloc = mine > 0u ? mine : 1u; nx = cnt > 0u ? cnt : 1u;
}

__device__ __forceinline__ void xcd_barrier(const XcdBarrier& b) {
    asm volatile("s_waitcnt vmcnt(0)" ::: "memory");
    __syncthreads();
    if (threadIdx.x == 0) {
        unsigned* bar = b.bar;
        __builtin_amdgcn_s_waitcnt(0);
        unsigned nloc = b.st[0], nx = b.st[1];
        if (nloc == 0u) { xcd_barrier_complete(bar, b.x, nloc, nx); b.st[0] = nloc; b.st[1] = nx; }
        const unsigned old = xb_add(&bar[XB_XSUB(b.x)], 1u);
        const unsigned gen = old / nloc;
        if (old + 1u == (gen + 1u) * nloc) {
            __builtin_amdgcn_fence(__ATOMIC_RELEASE, "agent");
            asm volatile("s_waitcnt vmcnt(0)" ::: "memory");
            const unsigned og = xb_add(&bar[XB_TOP], 1u);
            const unsigned tg = og / nx;
            if (og + 1u == (tg + 1u) * nx) xb_add(&bar[XB_TOPGEN], 1u);
            else XB_SPIN(xb_ld(&bar[XB_TOPGEN]) == tg, bar);
            __builtin_amdgcn_fence(__ATOMIC_ACQUIRE, "agent");
            xb_add(&bar[XB_XGEN(b.x)], 1u);
            asm volatile("s_waitcnt vmcnt(0)" ::: "memory");
        } else {
            XB_SPIN(xb_ld(&bar[XB_XGEN(b.x)]) == gen, bar);
            __builtin_amdgcn_fence(__ATOMIC_ACQUIRE, "agent");
            asm volatile("s_waitcnt vmcnt(0)" ::: "memory");
        }
    }
    __syncthreads();
}


struct Frame {
    LAS unsigned char* lds;
    volatile LAS unsigned* MISC;
    gu32* ctl;
    int tid, lane, wave;
    int vcu, G;
};
__device__ __forceinline__ float wave_sum(float v) {
#pragma unroll
    for (int o = 1; o < 64; o <<= 1) v += __shfl_xor(v, o);
    return v;
}
__device__ __forceinline__ float wave_max(float v) {
#pragma unroll
    for (int o = 1; o < 64; o <<= 1) v = fmaxf(v, __shfl_xor(v, o));
    return v;
}
__device__ __forceinline__ float bf2f(unsigned short h) { return __builtin_bit_cast(float, (unsigned)h << 16); }
__device__ __forceinline__ float bflo(unsigned w) { return __builtin_bit_cast(float, w << 16); }
__device__ __forceinline__ float bfhi(unsigned w) { return __builtin_bit_cast(float, w & 0xffff0000u); }
__device__ __forceinline__ void dsincos(double x, float& s, float& c) {
    const double k = __builtin_rint(x * 0.63661977236758134308);
    double r = __builtin_fma(-k, 1.57079632679489655800e+00, x); r = __builtin_fma(-k, 6.12323399573676603587e-17, r);
    const double r2 = r * r;
    double sp = -7.6471637318198164759e-13; sp = sp * r2 + 1.6059043836821614599e-10; sp = sp * r2 - 2.5052108385441718775e-08; sp = sp * r2 + 2.7557319223985890653e-06;
    sp = sp * r2 - 1.9841269841269841270e-04; sp = sp * r2 + 8.3333333333333333333e-03; sp = sp * r2 - 1.6666666666666666667e-01; sp = r + r * r2 * sp;
    double cp = 4.7794773323873852974e-14; cp = cp * r2 - 1.1470745597729724714e-11; cp = cp * r2 + 2.0876756987868098979e-09; cp = cp * r2 - 2.7557319223985890653e-07;
    cp = cp * r2 + 2.4801587301587301587e-05; cp = cp * r2 - 1.3888888888888888889e-03; cp = cp * r2 + 4.1666666666666666667e-02; cp = cp * r2 - 0.5; cp = 1.0 + r2 * cp;
    const int q = (int)((long long)k & 3);
    const double ss = (q & 1) ? cp : sp, cc = (q & 1) ? sp : cp;
    s = (float)((q & 2) ? -ss : ss); c = (float)(((q + 1) & 2) ? -cc : cc);
}

template <int MODE> __device__ __forceinline__ void p0_transpose_item(const float* W, int K, int N, bf16* WT, LAS float* scr, int item, int lane, const float* gk) {
    const int nblk = N / 32, kb = item / nblk, nb = item % nblk, k0 = 64 * kb, n0 = 32 * nb;
#pragma unroll 8
    for (int i = 0; i < 32; ++i) { const int kk = 2 * i + (lane >> 5); float w = W[(size_t)(k0 + kk) * N + n0 + (lane & 31)]; if (MODE == 2) w *= gk[k0 + kk]; scr[kk * 33 + (lane & 31)] = w; }
    LDS_WAIT(); asm volatile("" ::: "memory");
    const int c = lane & 7;
#pragma unroll
    for (int j = 0; j < 4; ++j) { const int n = (lane >> 3) + 8 * j; const LAS float* s = scr + (8 * c) * 33 + n;
        v4u o; o.x = pk2(s[0 * 33], s[1 * 33]); o.y = pk2(s[2 * 33], s[3 * 33]); o.z = pk2(s[4 * 33], s[5 * 33]); o.w = pk2(s[6 * 33], s[7 * 33]);
        int drow = n0 + n;
        if (MODE == 1 && drow < D_ATTN + D_KV) { const int d = drow & 63; drow = (drow & ~63) + 8 * ((d & 31) >> 2) + 4 * (d >> 5) + (d & 3); }
        *(GAS v4u*)(WT + (size_t)drow * K + k0 + 8 * c) = o; }
    LDS_WAIT(); asm volatile("" ::: "memory");
}
__device__ __forceinline__ void p0_gemv_item(const float* cvec, const float* w_ada, const float* b_ada, float* mod, int item, int lane) {
    const int nc = item % 96, kc = item / 96, n0 = nc * 256 + 4 * lane;
    f32x4 acc[4];
#pragma unroll
    for (int b = 0; b < 4; ++b) acc[b] = (f32x4){0.f, 0.f, 0.f, 0.f};
    for (int kh = 0; kh < 2; ++kh) { const int k0 = kc * 128 + kh * 64;
        float ca[4];
#pragma unroll
        for (int b = 0; b < 4; ++b) { const float cv = cvec[b * DM + k0 + lane]; ca[b] = cv / (1.0f + __expf(-cv)); }
        const GAS f32x4* wp = (const GAS f32x4*)(w_ada + (size_t)k0 * NMODC + n0);
#pragma unroll 8
        for (int kk = 0; kk < 64; ++kk) { const f32x4 w = wp[(size_t)kk * (NMODC / 4)];
#pragma unroll
            for (int b = 0; b < 4; ++b) { const float cb = __builtin_bit_cast(float, __builtin_amdgcn_readlane(__builtin_bit_cast(int, ca[b]), kk)); acc[b] += cb * w; } }
    }
    if (kc == 0) { const f32x4 bb = *(const GAS f32x4*)(b_ada + n0);
#pragma unroll
        for (int b = 0; b < 4; ++b) acc[b] += bb; }
#pragma unroll
    for (int b = 0; b < 4; ++b)
#pragma unroll
        for (int e = 0; e < 4; ++e) unsafeAtomicAdd(mod + b * NMODC + n0 + e, acc[b][e]);
}
struct In { const float *x, *c, *w_ada, *b_ada, *norm1_g, *w_in, *sinks, *lam_re, *lam_im, *log_step, *b_re, *b_im, *c_re, *c_im, *ssm_d, *w_glu, *b_glu, *attn_g, *ssm_g, *w_out, *norm2_g, *w_ff1, *w_ff2, *final_g; };
__device__ __forceinline__ void p0_prologue(Frame& F, const In& I, unsigned char* ws) {
    LAS float* scr = (LAS float*)(F.lds + RING_OFF + F.wave * 16384);
    const int gw = F.vcu * NWAVES + F.wave, NGW = F.G * NWAVES;
    float* mod = (float*)(ws + WS_MOD);
    for (int it = gw; it < 96 * 32; it += NGW) p0_gemv_item(I.c, I.w_ada, I.b_ada, mod, it, F.lane);
    constexpr int I_IN = (DM / 64) * (D_IN / 32), I_GLU = (D_SSM / 64) * (D_SSM / 32), I_OUT = (DM / 64) * (DM / 32), I_F1 = (DM / 64) * (D_FF / 32), I_F2 = (D_FF / 64) * (DM / 32);
    constexpr int NITEMS = I_IN + I_GLU + I_OUT + I_F1 + I_F2;
    bf16 *win = (bf16*)(ws + WS_WIN), *wglu = (bf16*)(ws + WS_WGLU), *wout = (bf16*)(ws + WS_WOUT), *wff1 = (bf16*)(ws + WS_WFF1), *wff2 = (bf16*)(ws + WS_WFF2);
    for (int it = gw; it < NITEMS; it += NGW) {
        int r = it;
        if (r < I_IN) { p0_transpose_item<1>(I.w_in, DM, D_IN, win, scr, r, F.lane, nullptr); continue; } r -= I_IN;
        if (r < I_GLU) { p0_transpose_item<0>(I.w_glu, D_SSM, D_SSM, wglu, scr, r, F.lane, nullptr); continue; } r -= I_GLU;
        if (r < I_OUT) { const int kb = r / (DM / 32); p0_transpose_item<2>(I.w_out, DM, DM, wout, scr, r, F.lane, kb < 32 ? I.attn_g : I.ssm_g - D_ATTN); continue; } r -= I_OUT;
        if (r < I_F1) { p0_transpose_item<0>(I.w_ff1, DM, D_FF, wff1, scr, r, F.lane, nullptr); continue; } r -= I_F1;
        p0_transpose_item<0>(I.w_ff2, D_FF, DM, wff2, scr, r, F.lane, nullptr);
    }
    float* rc = (float*)(ws + WS_ROPE); float* rs = rc + SEQ * 32;
    for (int idx = gw * 64 + F.lane; idx < SEQ * 32; idx += NGW * 64) { const int pos = idx >> 5, f = idx & 31;
        const float inv = exp2f(-(float)f * (13.287712379549449f / 32.0f)); const float ang = (float)pos * inv;
        float s, c; dsincos((double)ang, s, c); rc[idx] = c; rs[idx] = s; }
}
__device__ __forceinline__ void norm_mod_row(const float* xrow, const float* g, const float* scale, const float* shift, bf16* orow, int lane) {
    const GAS f32x4* xr = (const GAS f32x4*)xrow + lane;
    f32x4 v[16]; float s = 0.f;
#pragma unroll
    for (int j = 0; j < 16; ++j) { v[j] = xr[64 * j]; s += (v[j].x * v[j].x + v[j].y * v[j].y) + (v[j].z * v[j].z + v[j].w * v[j].w); }
    const float r = 1.0f / sqrtf(wave_sum(s) * (1.0f / DM) + EPS);
    GAS unsigned long long* o8 = (GAS unsigned long long*)orow + lane;
#pragma unroll
    for (int j = 0; j < 16; ++j) { const f32x4 gg = ((const GAS f32x4*)g)[64 * j + lane], sc = ((const GAS f32x4*)scale)[64 * j + lane], sh = ((const GAS f32x4*)shift)[64 * j + lane];
        const f32x4 o = (v[j] * r) * gg * (sc + 1.0f) + sh;
        o8[64 * j] = (unsigned long long)pk2(o.x, o.y) | ((unsigned long long)pk2(o.z, o.w) << 32); }
}
__device__ __forceinline__ void final_norm_row(float* xrow, const float* g, int lane) {
    GAS f32x4* xr = (GAS f32x4*)xrow + lane;
    f32x4 v[16]; float s = 0.f;
#pragma unroll
    for (int j = 0; j < 16; ++j) { v[j] = xr[64 * j]; s += (v[j].x * v[j].x + v[j].y * v[j].y) + (v[j].z * v[j].z + v[j].w * v[j].w); }
    const float r = 1.0f / sqrtf(wave_sum(s) * (1.0f / DM) + EPS);
#pragma unroll
    for (int j = 0; j < 16; ++j) { const f32x4 gg = ((const GAS f32x4*)g)[64 * j + lane]; xr[64 * j] = (v[j] * r) * gg; }
}
__device__ __forceinline__ void mix_scale_row(bf16* mrow, const float* ssa, const float* sss, int lane) {
    float p = lane < 32 ? ssa[lane] : sss[lane - 32];
#pragma unroll
    for (int o = 1; o < 32; o <<= 1) p += __shfl_xor(p, o);
    const float rmine = 1.0f / sqrtf(p * (1.0f / 2048.0f) + EPS), rother = __shfl_xor(rmine, 32);
    const float ra = lane < 32 ? rmine : rother, rs = lane < 32 ? rother : rmine;
    GAS v4u* mp = (GAS v4u*)mrow + lane;
#pragma unroll
    for (int j = 0; j < 8; ++j) { v4u w = mp[64 * j]; const float r = j < 4 ? ra : rs;
        w.x = pk2(bflo(w.x) * r, bfhi(w.x) * r); w.y = pk2(bflo(w.y) * r, bfhi(w.y) * r); w.z = pk2(bflo(w.z) * r, bfhi(w.z) * r); w.w = pk2(bflo(w.w) * r, bfhi(w.w) * r);
        mp[64 * j] = w; }
}

__device__ __forceinline__ void attn_phase_simple(Frame& F, const bf16* Q, const bf16* K, const bf16* V, bf16* O, float* SSA, const float* sinks) {
    LAS unsigned* Ks = (LAS unsigned*)(F.lds);
    LAS unsigned short* Vs = (LAS unsigned short*)(F.lds + 33792);
    LAS float* wsc = (LAS float*)(F.lds + 33792 + 32768 + F.wave * 1024);
    const int lane = F.lane;
    for (int unit = F.vcu; unit < BATCH * 32 * 4; unit += F.G) {
        const int kvh = unit & 3, nb = (unit >> 2) & 31, b = unit >> 7;
        const size_t tok0 = (size_t)b * SEQ + nb * 128;
        __syncthreads();
        for (int c = F.tid; c < 2048; c += NWAVES * 64) { const int kk = c >> 3, ch = c & 7;
            v4u kv = (v4u){0u, 0u, 0u, 0u}, vv = (v4u){0u, 0u, 0u, 0u};
            if (nb > 0 || kk >= 128) { const size_t r = tok0 - 128 + kk; kv = *(const GAS v4u*)(K + r * D_KV + kvh * 64 + ch * 8); vv = *(const GAS v4u*)(V + r * D_KV + kvh * 64 + ch * 8); }
            LAS unsigned* kd = Ks + kk * 33 + ch * 4; kd[0] = kv.x; kd[1] = kv.y; kd[2] = kv.z; kd[3] = kv.w;
            *(LAS v4u*)(Vs + kk * 64 + ch * 8) = vv; }
        __syncthreads();
        const int hq = kvh * 8 + F.wave; const float sink2 = sinks[hq] * LOG2E;
        for (int i = 0; i < 128; ++i) {
            const size_t row = tok0 + i;
            wsc[lane] = bf2f(Q[row * D_ATTN + hq * 64 + lane]);
            f32x4 q4[16];
#pragma unroll
            for (int j = 0; j < 16; ++j) q4[j] = *(const LAS f32x4*)(wsc + 4 * j);
            const int kA = i + 1 + lane, kB = kA + 64;
            float sA = 0.f, sB = 0.f;
#pragma unroll
            for (int j = 0; j < 16; ++j) { const unsigned a0 = Ks[kA * 33 + 2 * j], a1 = Ks[kA * 33 + 2 * j + 1], b0 = Ks[kB * 33 + 2 * j], b1 = Ks[kB * 33 + 2 * j + 1];
                sA += q4[j].x * bflo(a0) + q4[j].y * bfhi(a0) + q4[j].z * bflo(a1) + q4[j].w * bfhi(a1);
                sB += q4[j].x * bflo(b0) + q4[j].y * bfhi(b0) + q4[j].z * bflo(b1) + q4[j].w * bfhi(b1); }
            if (nb == 0) { if (kA < 128) sA = -INFINITY; if (kB < 128) sB = -INFINITY; }
            const float mx = fmaxf(wave_max(fmaxf(sA, sB)), sink2);
            const float pA = exp2f(sA - mx), pB = exp2f(sB - mx);
            const float den = wave_sum(pA + pB) + exp2f(sink2 - mx);
            wsc[64 + lane] = pA; wsc[128 + lane] = pB;
            float o = 0.f;
#pragma unroll 8
            for (int l4 = 0; l4 < 32; ++l4) { const f32x4 p4 = *(const LAS f32x4*)(wsc + 64 + 4 * l4); const LAS unsigned short* vp = Vs + (i + 1 + 4 * l4) * 64 + lane;
                o += p4.x * bf2f(vp[0]) + p4.y * bf2f(vp[64]) + p4.z * bf2f(vp[128]) + p4.w * bf2f(vp[192]); }
            o = o / den;
            const unsigned ob = f2bf(o); const float of = bf2f((unsigned short)ob);
            const float ss = wave_sum(of * of);
            O[row * DM + hq * 64 + lane] = (bf16)ob;
            if (lane == 0) SSA[row * 32 + hq] = ss;
        }
    }
}

__device__ __forceinline__ float erf_gelu(float y) { return 0.5f * y * (1.0f + erff(y * 0.70710678118654752f)); }
__device__ __forceinline__ void ssm_phase_simple(Frame& F, const In& I, const bf16* U, bf16* YG) {
    const int lane = F.lane, w = F.wave;
    LAS unsigned* ul = (LAS unsigned*)(F.lds + w * 4096);
    LAS unsigned short* yl = (LAS unsigned short*)(F.lds + w * 4096 + 2048);
    LAS float* E = (LAS float*)(F.lds + 32768);
    for (int unit = F.vcu; unit < BATCH * 128; unit += F.G) {
        const int b = unit >> 7, g = unit & 127, p = lane;
        const float step = expf(I.log_step[g]), lre = I.lam_re[g * 64 + p], lim = I.lam_im[g * 64 + p];
        float lr, li; { const float er = expf(lre * step); float s, c; dsincos((double)(lim * step), s, c); lr = er * c; li = er * s; }
        float cfr, cfi; { const float nr = lr - 1.0f, ni = li, den = lre * lre + lim * lim; cfr = (nr * lre + ni * lim) / den; cfi = (ni * lre - nr * lim) / den; }
        float bbr[16], bbi[16], cr[16], ci[16];
#pragma unroll
        for (int h4 = 0; h4 < 4; ++h4) { const f32x4 br = *(const GAS f32x4*)(I.b_re + (size_t)(g * 64 + p) * 16 + 4 * h4), bi = *(const GAS f32x4*)(I.b_im + (size_t)(g * 64 + p) * 16 + 4 * h4);
#pragma unroll
            for (int e = 0; e < 4; ++e) { bbr[4 * h4 + e] = cfr * br[e] - cfi * bi[e]; bbi[4 * h4 + e] = cfr * bi[e] + cfi * br[e]; } }
#pragma unroll
        for (int h = 0; h < 16; ++h) { cr[h] = I.c_re[(size_t)(g * 16 + h) * 64 + p]; ci[h] = I.c_im[(size_t)(g * 16 + h) * 64 + p]; }
        float l5r = lr, l5i = li;
#pragma unroll
        for (int k = 0; k < 9; ++k) { const float nr = l5r * l5r - l5i * l5i, ni = 2.0f * l5r * l5i; l5r = nr; l5i = ni; }
        const float dsk = I.ssm_d[g * 16 + (lane >> 2)];
        const size_t row0 = (size_t)b * SEQ + w * 512;
        __syncthreads();
        float sr = 0.f, si = 0.f;
        for (int c = 0; c < 8; ++c) {
            { const GAS v4u* up = (const GAS v4u*)(U + (row0 + c * 64 + lane) * D_SSM + g * 16); const v4u a = up[0], bq = up[1];
              *(LAS v4u*)(ul + lane * 8) = a; *(LAS v4u*)(ul + lane * 8 + 4) = bq; }
            for (int tt = 0; tt < 64; ++tt) { const v4u a = *(const LAS v4u*)(ul + tt * 8), bq = *(const LAS v4u*)(ul + tt * 8 + 4);
                const float uu[16] = {bflo(a.x), bfhi(a.x), bflo(a.y), bfhi(a.y), bflo(a.z), bfhi(a.z), bflo(a.w), bfhi(a.w), bflo(bq.x), bfhi(bq.x), bflo(bq.y), bfhi(bq.y), bflo(bq.z), bfhi(bq.z), bflo(bq.w), bfhi(bq.w)};
                float zr = 0.f, zi = 0.f;
#pragma unroll
                for (int h = 0; h < 16; ++h) { zr += bbr[h] * uu[h]; zi += bbi[h] * uu[h]; }
                const float nr = lr * sr - li * si + zr, ni = lr * si + li * sr + zi; sr = nr; si = ni; }
        }
        E[(w * 64 + lane) * 2] = sr; E[(w * 64 + lane) * 2 + 1] = si;
        __syncthreads();
        sr = 0.f; si = 0.f;
        for (int wp = 0; wp < w; ++wp) { const float er = E[(wp * 64 + lane) * 2], ei = E[(wp * 64 + lane) * 2 + 1];
            const float nr = l5r * sr - l5i * si + er, ni = l5r * si + l5i * sr + ei; sr = nr; si = ni; }
        for (int c = 0; c < 8; ++c) {
            { const GAS v4u* up = (const GAS v4u*)(U + (row0 + c * 64 + lane) * D_SSM + g * 16); const v4u a = up[0], bq = up[1];
              *(LAS v4u*)(ul + lane * 8) = a; *(LAS v4u*)(ul + lane * 8 + 4) = bq; }
            for (int tt = 0; tt < 64; ++tt) { const v4u a = *(const LAS v4u*)(ul + tt * 8), bq = *(const LAS v4u*)(ul + tt * 8 + 4);
                const float uu[16] = {bflo(a.x), bfhi(a.x), bflo(a.y), bfhi(a.y), bflo(a.z), bfhi(a.z), bflo(a.w), bfhi(a.w), bflo(bq.x), bfhi(bq.x), bflo(bq.y), bfhi(bq.y), bflo(bq.z), bfhi(bq.z), bflo(bq.w), bfhi(bq.w)};
                float zr = 0.f, zi = 0.f;
#pragma unroll
                for (int h = 0; h < 16; ++h) { zr += bbr[h] * uu[h]; zi += bbi[h] * uu[h]; }
                const float nr = lr * sr - li * si + zr, ni = lr * si + li * sr + zi; sr = nr; si = ni;
                float v[16];
#pragma unroll
                for (int h = 0; h < 16; ++h) v[h] = cr[h] * sr - ci[h] * si;
#pragma unroll
                for (int i = 0; i < 8; ++i) { const bool hi = lane & 32; const float keep = hi ? v[i + 8] : v[i], send = hi ? v[i] : v[i + 8]; v[i] = keep + __shfl_xor(send, 32); }
#pragma unroll
                for (int i = 0; i < 4; ++i) { const bool hi = lane & 16; const float keep = hi ? v[i + 4] : v[i], send = hi ? v[i] : v[i + 4]; v[i] = keep + __shfl_xor(send, 16); }
#pragma unroll
                for (int i = 0; i < 2; ++i) { const bool hi = lane & 8; const float keep = hi ? v[i + 2] : v[i], send = hi ? v[i] : v[i + 2]; v[i] = keep + __shfl_xor(send, 8); }
                { const bool hi = lane & 4; const float keep = hi ? v[1] : v[0], send = hi ? v[0] : v[1]; v[0] = keep + __shfl_xor(send, 4); }
                float y = v[0]; y += __shfl_xor(y, 2); y += __shfl_xor(y, 1);
                const LAS unsigned short* ul16 = (const LAS unsigned short*)ul;
                y += dsk * bf2f(ul16[tt * 16 + (lane >> 2)]);
                y = erf_gelu(y);
                if ((lane & 3) == 0) yl[tt * 16 + (lane >> 2)] = (unsigned short)f2bf(y);
            }
            { const v4u a = *(const LAS v4u*)(yl + lane * 16), bq = *(const LAS v4u*)(yl + lane * 16 + 8);
              GAS v4u* yp = (GAS v4u*)(YG + (row0 + c * 64 + lane) * D_SSM + g * 16); yp[0] = a; yp[1] = bq; }
        }
    }
}


typedef float f32x16 __attribute__((ext_vector_type(16)));
typedef float f32x2v __attribute__((ext_vector_type(2)));
__device__ __forceinline__ bf16x8 pack8(float a0, float a1, float a2, float a3, float a4, float a5, float a6, float a7) {
    v4u w; w.x = pg8::cvt_pk_bf16(a0, a1); w.y = pg8::cvt_pk_bf16(a2, a3); w.z = pg8::cvt_pk_bf16(a4, a5); w.w = pg8::cvt_pk_bf16(a6, a7); return __builtin_bit_cast(bf16x8, w); }
__device__ __forceinline__ void ssm_phase_mfma(Frame& F, const In& I, const bf16* U, bf16* YG) {
    const int lane = F.lane, w = F.wave, n = lane & 31, h = lane >> 5, t16 = lane & 15, kq = lane >> 4;
    LAS unsigned* St = (LAS unsigned*)(F.lds + w * 8704);
    LAS float* E = (LAS float*)(F.lds + 8 * 8704);
    for (int unit = F.vcu; unit < 256; unit += F.G) {
        const int g = unit >> 1, bp = unit & 1;
        const float step = expf(I.log_step[g]);
        float lr[2], li[2], l5r[2], l5i[2]; bf16x8 Bf[4];
#pragma unroll
        for (int q = 0; q < 2; ++q) { const int p = n + 32 * q; const float lre = I.lam_re[g * 64 + p], lim = I.lam_im[g * 64 + p];
            { const float er = expf(lre * step); float s, c; dsincos((double)(lim * step), s, c); lr[q] = er * c; li[q] = er * s; }
            const float nr = lr[q] - 1.0f, ni = li[q], den = lre * lre + lim * lim, cfr = (nr * lre + ni * lim) / den, cfi = (ni * lre - nr * lim) / den;
            float a = lr[q], bq = li[q];
#pragma unroll
            for (int k = 0; k < 9; ++k) { const float xr = a * a - bq * bq, xi = 2.0f * a * bq; a = xr; bq = xi; }
            l5r[q] = a; l5i[q] = bq;
            const GAS f32x4* brp = (const GAS f32x4*)(I.b_re + (size_t)(g * 64 + p) * 16 + 8 * h); const GAS f32x4* bip = (const GAS f32x4*)(I.b_im + (size_t)(g * 64 + p) * 16 + 8 * h);
            const f32x4 br0 = brp[0], br1 = brp[1], bi0 = bip[0], bi1 = bip[1];
            const f32x4 re0 = cfr * br0 - cfi * bi0, re1 = cfr * br1 - cfi * bi1, im0 = cfr * bi0 + cfi * br0, im1 = cfr * bi1 + cfi * br1;
            Bf[q] = pack8(re0[0], re0[1], re0[2], re0[3], re1[0], re1[1], re1[2], re1[3]);
            Bf[2 + q] = pack8(im0[0], im0[1], im0[2], im0[3], im1[0], im1[1], im1[2], im1[3]); }
        bf16x8 Cf[4];
#pragma unroll
        for (int ks = 0; ks < 4; ++ks) { const f32x4 c_r = *(const GAS f32x4*)(I.c_re + (size_t)(g * 16 + t16) * 64 + 16 * ks + 4 * kq), c_i = *(const GAS f32x4*)(I.c_im + (size_t)(g * 16 + t16) * 64 + 16 * ks + 4 * kq);
            Cf[ks] = pack8(c_r[0], -c_i[0], c_r[1], -c_i[1], c_r[2], -c_i[2], c_r[3], -c_i[3]); }
        const f32x4 dsk = *(const GAS f32x4*)(I.ssm_d + g * 16 + 4 * kq);
        const int aseq = (n >> 2) & 1, atok = 4 * (n >> 3) + (n & 3);
        const bf16* ua = U + ((size_t)(2 * bp + aseq) * SEQ + w * 512 + atok) * D_SSM + g * 16 + 8 * h;
        __syncthreads();
        float s0r = 0.f, s0i = 0.f, s1r = 0.f, s1i = 0.f;
        const f32x16 zero16 = {0.f, 0.f, 0.f, 0.f, 0.f, 0.f, 0.f, 0.f, 0.f, 0.f, 0.f, 0.f, 0.f, 0.f, 0.f, 0.f};
        for (int st = 0; st < 32; ++st) {
            const bf16x8 a = *(const GAS bf16x8*)(ua + (size_t)st * 16 * D_SSM);
            const f32x16 z0 = __builtin_amdgcn_mfma_f32_32x32x16_bf16(a, Bf[0], zero16, 0, 0, 0), z1 = __builtin_amdgcn_mfma_f32_32x32x16_bf16(a, Bf[1], zero16, 0, 0, 0);
            const f32x16 z2 = __builtin_amdgcn_mfma_f32_32x32x16_bf16(a, Bf[2], zero16, 0, 0, 0), z3 = __builtin_amdgcn_mfma_f32_32x32x16_bf16(a, Bf[3], zero16, 0, 0, 0);
#pragma unroll
            for (int r = 0; r < 16; ++r) { const float ar = lr[0] * s0r - li[0] * s0i + z0[r], ai = lr[0] * s0i + li[0] * s0r + z2[r]; s0r = ar; s0i = ai;
                                           const float br = lr[1] * s1r - li[1] * s1i + z1[r], bi = lr[1] * s1i + li[1] * s1r + z3[r]; s1r = br; s1i = bi; }
        }
        *(LAS f32x4*)(E + (w * 64 + lane) * 4) = (f32x4){s0r, s0i, s1r, s1i};
        __syncthreads();
        s0r = 0.f; s0i = 0.f; s1r = 0.f; s1i = 0.f;
        for (int wp = 0; wp < w; ++wp) { const f32x4 e = *(const LAS f32x4*)(E + (wp * 64 + lane) * 4);
            const float ar = l5r[0] * s0r - l5i[0] * s0i + e[0], ai = l5r[0] * s0i + l5i[0] * s0r + e[1]; s0r = ar; s0i = ai;
            const float br = l5r[1] * s1r - l5i[1] * s1i + e[2], bi = l5r[1] * s1i + l5i[1] * s1r + e[3]; s1r = br; s1i = bi; }
        for (int st = 0; st < 32; ++st) {
            const bf16x8 a = *(const GAS bf16x8*)(ua + (size_t)st * 16 * D_SSM);
            const f32x16 z0 = __builtin_amdgcn_mfma_f32_32x32x16_bf16(a, Bf[0], zero16, 0, 0, 0), z1 = __builtin_amdgcn_mfma_f32_32x32x16_bf16(a, Bf[1], zero16, 0, 0, 0);
            const f32x16 z2 = __builtin_amdgcn_mfma_f32_32x32x16_bf16(a, Bf[2], zero16, 0, 0, 0), z3 = __builtin_amdgcn_mfma_f32_32x32x16_bf16(a, Bf[3], zero16, 0, 0, 0);
#pragma unroll
            for (int r = 0; r < 16; ++r) { const float ar = lr[0] * s0r - li[0] * s0i + z0[r], ai = lr[0] * s0i + li[0] * s0r + z2[r]; s0r = ar; s0i = ai;
                                           const float br = lr[1] * s1r - li[1] * s1i + z1[r], bi = lr[1] * s1i + li[1] * s1r + z3[r]; s1r = br; s1i = bi;
                                           St[(h * 16 + r) * 68 + n] = pg8::cvt_pk_bf16(s0r, s0i); St[(h * 16 + r) * 68 + 32 + n] = pg8::cvt_pk_bf16(s1r, s1i); }
#pragma unroll
            for (int s = 0; s < 2; ++s) { f32x4 acc = (f32x4){0.f, 0.f, 0.f, 0.f};
#pragma unroll
                for (int ks = 0; ks < 4; ++ks) { const bf16x8 sb = *(const LAS bf16x8*)(St + (s * 16 + t16) * 68 + 16 * ks + 4 * kq); acc = __builtin_amdgcn_mfma_f32_16x16x32_bf16(Cf[ks], sb, acc, 0, 0, 0); }
                const size_t off = ((size_t)(2 * bp + s) * SEQ + w * 512 + st * 16 + t16) * D_SSM + g * 16 + 4 * kq;
                const unsigned long long uw = *(const GAS unsigned long long*)(U + off);
                const unsigned u01 = (unsigned)uw, u23 = (unsigned)(uw >> 32);
                const pg8::f32x2 y01 = pg8::gelu_pk((pg8::f32x2){acc[0] + dsk[0] * bflo(u01), acc[1] + dsk[1] * bfhi(u01)});
                const pg8::f32x2 y23 = pg8::gelu_pk((pg8::f32x2){acc[2] + dsk[2] * bflo(u23), acc[3] + dsk[3] * bfhi(u23)});
                *(GAS unsigned long long*)(YG + off) = (unsigned long long)pg8::cvt_pk_bf16(y01.x, y01.y) | ((unsigned long long)pg8::cvt_pk_bf16(y23.x, y23.y) << 32); }
        }
    }
}


__device__ __forceinline__ void attn_phase_mfma(Frame& F, const bf16* Q, const bf16* K, const bf16* V, bf16* O, float* SSA, const float* sinks) {
    constexpr int KRS = 72, VRS = 260;
    LAS unsigned short* Ks = (LAS unsigned short*)(F.lds);
    LAS unsigned short* Vt = (LAS unsigned short*)(F.lds + 36864);
    const int lane = F.lane, w = F.wave, q = lane & 31, h = lane >> 5;
    for (int unit = F.vcu; unit < BATCH * 32 * 4; unit += F.G) {
        const int kvh = unit & 3, nb = (unit >> 2) & 31, b = unit >> 7;
        const size_t tok0 = (size_t)b * SEQ + nb * 128;
        __syncthreads();
        for (int c = F.tid; c < 2048; c += NWAVES * 64) { const int kk = c >> 3, ch = c & 7;
            v4u kv = (v4u){0u, 0u, 0u, 0u}, vv = (v4u){0u, 0u, 0u, 0u};
            if (nb > 0 || kk >= 128) { const size_t r = tok0 - 128 + kk; kv = *(const GAS v4u*)(K + r * D_KV + kvh * 64 + ch * 8); vv = *(const GAS v4u*)(V + r * D_KV + kvh * 64 + ch * 8); }
            *(LAS v4u*)(Ks + kk * KRS + ch * 8) = kv;
            LAS unsigned short* vd = Vt + (ch * 8) * VRS + kk;
            vd[0 * VRS] = (unsigned short)vv.x; vd[1 * VRS] = (unsigned short)(vv.x >> 16); vd[2 * VRS] = (unsigned short)vv.y; vd[3 * VRS] = (unsigned short)(vv.y >> 16);
            vd[4 * VRS] = (unsigned short)vv.z; vd[5 * VRS] = (unsigned short)(vv.z >> 16); vd[6 * VRS] = (unsigned short)vv.w; vd[7 * VRS] = (unsigned short)(vv.w >> 16); }
        __syncthreads();
        const int hq = kvh * 8 + w; const float sink2 = sinks[hq] * LOG2E;
        for (int mt = 0; mt < 4; ++mt) {
            const size_t row = tok0 + 32 * mt + q;
            bf16x8 qf[4];
#pragma unroll
            for (int ds = 0; ds < 4; ++ds) qf[ds] = *(const GAS bf16x8*)(Q + row * D_ATTN + hq * 64 + 16 * ds + 8 * h);
            f32x16 s[5];
#pragma unroll
            for (int t = 0; t < 5; ++t) { s[t] = (f32x16){0.f, 0.f, 0.f, 0.f, 0.f, 0.f, 0.f, 0.f, 0.f, 0.f, 0.f, 0.f, 0.f, 0.f, 0.f, 0.f};
#pragma unroll
                for (int ds = 0; ds < 4; ++ds) { const bf16x8 kf = *(const LAS bf16x8*)(Ks + (32 * (mt + t) + q) * KRS + 16 * ds + 8 * h); s[t] = __builtin_amdgcn_mfma_f32_32x32x16_bf16(kf, qf[ds], s[t], 0, 0, 0); } }
#pragma unroll
            for (int r = 0; r < 16; ++r) { const int i = 8 * (r >> 2) + 4 * h + (r & 3); if (i <= q) s[0][r] = -INFINITY; if (i > q) s[4][r] = -INFINITY; }
            if (nb == 0) {
#pragma unroll
                for (int t = 0; t < 4; ++t) if (mt + t < 4) {
#pragma unroll
                    for (int r = 0; r < 16; ++r) s[t][r] = -INFINITY; } }
            float mx = sink2;
#pragma unroll
            for (int t = 0; t < 5; ++t)
#pragma unroll
                for (int r = 0; r < 16; ++r) mx = fmaxf(mx, s[t][r]);
            mx = fmaxf(mx, __shfl_xor(mx, 32));
            float sum = 0.f;
#pragma unroll
            for (int t = 0; t < 5; ++t)
#pragma unroll
                for (int r = 0; r < 16; ++r) { const float p = exp2f(s[t][r] - mx); s[t][r] = p; sum += p; }
            sum += __shfl_xor(sum, 32);
            const float inv = 1.0f / (sum + exp2f(sink2 - mx));
            f32x16 o0 = (f32x16){0.f, 0.f, 0.f, 0.f, 0.f, 0.f, 0.f, 0.f, 0.f, 0.f, 0.f, 0.f, 0.f, 0.f, 0.f, 0.f}, o1 = o0;
#pragma unroll
            for (int t = 0; t < 5; ++t)
#pragma unroll
                for (int k2 = 0; k2 < 2; ++k2) {
                    const bf16x8 pb = pack8(s[t][8 * k2 + 0], s[t][8 * k2 + 1], s[t][8 * k2 + 2], s[t][8 * k2 + 3], s[t][8 * k2 + 4], s[t][8 * k2 + 5], s[t][8 * k2 + 6], s[t][8 * k2 + 7]);
                    const int kb = 32 * (mt + t) + 16 * k2 + 4 * h;
                    typedef unsigned u32x2v __attribute__((ext_vector_type(2)));
                    const u32x2v a0 = *(const LAS u32x2v*)(Vt + q * VRS + kb), a1 = *(const LAS u32x2v*)(Vt + q * VRS + kb + 8);
                    const u32x2v c0 = *(const LAS u32x2v*)(Vt + (q + 32) * VRS + kb), c1 = *(const LAS u32x2v*)(Vt + (q + 32) * VRS + kb + 8);
                    const bf16x8 va0 = __builtin_bit_cast(bf16x8, (v4u){a0.x, a0.y, a1.x, a1.y}), va1 = __builtin_bit_cast(bf16x8, (v4u){c0.x, c0.y, c1.x, c1.y});
                    o0 = __builtin_amdgcn_mfma_f32_32x32x16_bf16(va0, pb, o0, 0, 0, 0); o1 = __builtin_amdgcn_mfma_f32_32x32x16_bf16(va1, pb, o1, 0, 0, 0); }
            float ss = 0.f;
            bf16* orow = O + row * DM + hq * 64 + 4 * h;
#pragma unroll
            for (int a = 0; a < 4; ++a) {
                const unsigned w0 = pg8::cvt_pk_bf16(o0[4 * a] * inv, o0[4 * a + 1] * inv), w1 = pg8::cvt_pk_bf16(o0[4 * a + 2] * inv, o0[4 * a + 3] * inv);
                const unsigned x0 = pg8::cvt_pk_bf16(o1[4 * a] * inv, o1[4 * a + 1] * inv), x1 = pg8::cvt_pk_bf16(o1[4 * a + 2] * inv, o1[4 * a + 3] * inv);
                ss += bflo(w0) * bflo(w0) + bfhi(w0) * bfhi(w0) + bflo(w1) * bflo(w1) + bfhi(w1) * bfhi(w1) + bflo(x0) * bflo(x0) + bfhi(x0) * bfhi(x0) + bflo(x1) * bflo(x1) + bfhi(x1) * bfhi(x1);
                *(GAS unsigned long long*)(orow + 8 * a) = (unsigned long long)w0 | ((unsigned long long)w1 << 32);
                *(GAS unsigned long long*)(orow + 32 + 8 * a) = (unsigned long long)x0 | ((unsigned long long)x1 << 32); }
            ss += __shfl_xor(ss, 32);
            if (h == 0) SSA[row * 32 + hq] = ss;
        }
    }
}

struct Args { const float* in[24]; float* out; unsigned char* ws; };
__global__ void __launch_bounds__(NWAVES * 64, 2) hymba_fwd(Args args) {
    extern __shared__ __attribute__((aligned(16))) unsigned char lds[];
    Frame F;
    F.lds = (LAS unsigned char*)lds;
    F.MISC = (volatile LAS unsigned*)(F.lds + MISC_OFF);
    F.tid = threadIdx.x; F.lane = F.tid & 63; F.wave = __builtin_amdgcn_readfirstlane(F.tid >> 6);
    F.G = gridDim.x; { const int bx = blockIdx.x; F.vcu = (F.G % 8 == 0) ? (bx % 8) * (F.G / 8) + bx / 8 : bx; }
    unsigned char* ws = args.ws;
    F.ctl = (gu32*)(ws + WS_CTL);
    In I;
    I.x = args.in[0]; I.c = args.in[1]; I.w_ada = args.in[2]; I.b_ada = args.in[3]; I.norm1_g = args.in[4]; I.w_in = args.in[5]; I.sinks = args.in[6];
    I.lam_re = args.in[7]; I.lam_im = args.in[8]; I.log_step = args.in[9]; I.b_re = args.in[10]; I.b_im = args.in[11]; I.c_re = args.in[12]; I.c_im = args.in[13];
    I.ssm_d = args.in[14]; I.w_glu = args.in[15]; I.b_glu = args.in[16]; I.attn_g = args.in[17]; I.ssm_g = args.in[18]; I.w_out = args.in[19]; I.norm2_g = args.in[20];
    I.w_ff1 = args.in[21]; I.w_ff2 = args.in[22]; I.final_g = args.in[23];
    float* out = args.out;
    const float* mod = (const float*)(ws + WS_MOD);
    bf16 *Wi = (bf16*)(ws + WS_WIN), *Wg = (bf16*)(ws + WS_WGLU), *Wo = (bf16*)(ws + WS_WOUT), *W1 = (bf16*)(ws + WS_WFF1), *W2 = (bf16*)(ws + WS_WFF2);
    bf16 *H = (bf16*)(ws + WS_H), *Qb = (bf16*)(ws + WS_Q), *Kb = (bf16*)(ws + WS_K), *Vb = (bf16*)(ws + WS_V), *Ub = (bf16*)(ws + WS_U);
    bf16 *MIX = (bf16*)(ws + WS_MIX), *YG = (bf16*)(ws + WS_YG), *HID = (bf16*)(ws + WS_HID);
    float *SSA = (float*)(ws + WS_SSA), *SSS = (float*)(ws + WS_SSS);
    const float* rcos = (const float*)(ws + WS_ROPE); const float* rsin = rcos + SEQ * 32;
    for (int u = F.tid; u < (LDS_BYTES - LDSCTL_OFF) / 4; u += NWAVES * 64) ((LAS unsigned*)(F.lds + LDSCTL_OFF))[u] = 0u;
    __syncthreads();
    XcdBarrier bar = xcd_barrier_post((unsigned*)(F.ctl + CW_BAR), F.MISC + 8);
    const int gw = F.vcu * NWAVES + F.wave, NGW = F.G * NWAVES;

    p0_prologue(F, I, ws);
    xcd_barrier(bar);
    for (int m = gw; m < M; m += NGW) { const float* mb = mod + (size_t)(m >> 12) * NMODC; norm_mod_row(I.x + (size_t)m * DM, I.norm1_g, mb + DM, mb, H + (size_t)m * DM, F.lane); }
    xcd_barrier(bar);
    { pg8::Gemm g{H, Wi, M, D_IN, DM}; pg8::StaticOrder S; S.init(M, D_IN, F.G, (int)blockIdx.x);
      pg8::EpiIn E{Qb, Kb, Vb, Ub, rcos, rsin, 0.125f * LOG2E};
      pg8::gemm_phase<pg8::EpiIn, pg8::StaticOrder, true, true>(F.lds + RING_OFF, g, S, E); }
    xcd_barrier(bar);
    attn_phase_mfma(F, Qb, Kb, Vb, MIX, SSA, I.sinks);
    ssm_phase_mfma(F, I, Ub, YG);
    xcd_barrier(bar);
    { pg8::Gemm g{YG, Wg, M, D_SSM, D_SSM}; pg8::StaticOrder S; S.init(M, D_SSM, F.G, (int)blockIdx.x);
      pg8::EpiGlu E{YG, I.b_glu, MIX, SSS};
      pg8::gemm_phase<pg8::EpiGlu, pg8::StaticOrder, true, true>(F.lds + RING_OFF, g, S, E); }
    xcd_barrier(bar);
    for (int m = gw; m < M; m += NGW) mix_scale_row(MIX + (size_t)m * DM, SSA + (size_t)m * 32, SSS + (size_t)m * 32, F.lane);
    xcd_barrier(bar);
    { pg8::Gemm g{MIX, Wo, M, DM, DM}; pg8::StaticOrder S; S.init(M, DM, F.G, (int)blockIdx.x);
      pg8::EpiRes E{I.x, out, mod + 2 * DM};
      pg8::gemm_phase<pg8::EpiRes, pg8::StaticOrder, true, true>(F.lds + RING_OFF, g, S, E); }
    xcd_barrier(bar);
    for (int m = gw; m < M; m += NGW) { const float* mb = mod + (size_t)(m >> 12) * NMODC; norm_mod_row(out + (size_t)m * DM, I.norm2_g, mb + 4 * DM, mb + 3 * DM, H + (size_t)m * DM, F.lane); }
    xcd_barrier(bar);
    { pg8::Gemm g{H, W1, M, D_FF, DM}; pg8::StaticOrder S; S.init(M, D_FF, F.G, (int)blockIdx.x);
      pg8::EpiSqRelu E{HID, D_FF};
      pg8::gemm_phase<pg8::EpiSqRelu, pg8::StaticOrder, true, true>(F.lds + RING_OFF, g, S, E); }
    xcd_barrier(bar);
    { pg8::Gemm g{HID, W2, M, DM, D_FF}; pg8::StaticOrder S; S.init(M, DM, F.G, (int)blockIdx.x);
      pg8::EpiRes E{out, out, mod + 5 * DM};
      pg8::gemm_phase<pg8::EpiRes, pg8::StaticOrder, true, true>(F.lds + RING_OFF, g, S, E); }
    xcd_barrier(bar);
    for (int m = gw; m < M; m += NGW) final_norm_row(out + (size_t)m * DM, I.final_g, F.lane);
}

extern "C" void kernel_launch(void* const* d_in, const int* in_sizes, int n_in, void* d_out, int out_size, void* d_ws, size_t ws_size, hipStream_t stream) {
    static int grid = 0;
    if (grid == 0) {
        if (n_in != 24 || in_sizes[0] != M * DM || out_size != M * DM || ws_size < WS_END) { fprintf(stderr, "kernel_launch: unexpected shapes: n_in %d in0 %d out %d ws %zu (need %zu); nothing launched\n", n_in, n_in > 0 ? in_sizes[0] : -1, out_size, ws_size, (size_t)WS_END); grid = -1; return; }
        int dev = 0, cus = 0, per_cu = 0;
        if (hipGetDevice(&dev) != hipSuccess || hipDeviceGetAttribute(&cus, hipDeviceAttributeMultiprocessorCount, dev) != hipSuccess) { grid = -1; return; }
        if (hipFuncSetAttribute((const void*)hymba_fwd, hipFuncAttributeMaxDynamicSharedMemorySize, LDS_BYTES) != hipSuccess) { fprintf(stderr, "kernel_launch: hipFuncSetAttribute failed\n"); grid = -1; return; }
        if (hipOccupancyMaxActiveBlocksPerMultiprocessor(&per_cu, (const void*)hymba_fwd, NWAVES * 64, LDS_BYTES) != hipSuccess || per_cu < 1)
            fprintf(stderr, "kernel_launch: note: occupancy query reports %d workgroups per CU\n", per_cu);
        (void)hipGetLastError();
        grid = cus;
    }
    if (grid < 0) return;
    if (hipMemsetAsync((char*)d_ws + WS_CTL, 0, CTL_ZERO_BYTES, stream) != hipSuccess) return;
    Args a{};
    for (int i = 0; i < 24; ++i) a.in[i] = (const float*)d_in[i];
    a.out = (float*)d_out; a.ws = (unsigned char*)d_ws;
    hipLaunchKernelGGL(hymba_fwd, dim3(grid), dim3(NWAVES * 64), LDS_BYTES, stream, a);
}
```

```cpp
#include <hip/hip_runtime.h>
#include <cstdio>
#include <cstdint>
namespace pg8 {
#define PG8_LAS __attribute__((address_space(3)))
typedef unsigned short bf16_t;
typedef short bf16x8 __attribute__((ext_vector_type(8)));
typedef float f32x4 __attribute__((ext_vector_type(4)));
typedef unsigned u32x4 __attribute__((ext_vector_type(4)));
constexpr int BM = 256, BK = 64, HALF = 128, HTB = HALF * BK * 2  , STAGE_BYTES = 8 * HTB, NXCD = 8, WGM = 8;

__host__ __device__ __forceinline__ int lds_byte(int r, int c) { const int st = (r >> 4) * 2 + (c >> 5), rr = r & 15, cc = c & 31, ob = rr * 64 + cc * 2; return st * 1024 + (ob ^ (((ob >> 9) & 1) << 5)); }
__host__ __device__ __forceinline__ void stage_rc(int b, int& R, int& C) { const int st = b / 1024, sb = b % 1024, swz = sb ^ (((sb >> 9) & 1) << 5); R = (st >> 1) * 16 + swz / 64; C = (st & 1) * 32 + (swz % 64) / 2; }
__host__ __device__ __forceinline__ int perm32(int rho) { const int n = rho >> 4, i = rho & 15; return 8 * (i >> 2) + 4 * n + (i & 3); }

struct Unit { int pm, pn; };
struct Gemm { const bf16_t* A; const bf16_t* Bt; int M, N, K; };

struct StaticOrder {
    int nM, nN, nwg, G, c, wgm;
    __host__ __device__ void init(int M, int N, int G_, int c_, int wgm_ = WGM) { nM = M / BM; nN = N / BM; nwg = nM * nN; G = G_; c = c_; wgm = wgm_; }
    __host__ __device__ bool next(int i, Unit& u) const {
        const long L = (long)i * G + c; if (L >= nwg) return false;
        int wgid = (int)L; { const int q = nwg / NXCD, r = nwg % NXCD, xcd = wgid % NXCD, off = wgid / NXCD; wgid = (xcd < r ? xcd * (q + 1) : r * (q + 1) + (xcd - r) * q) + off; }
        const int nig = wgm * nN, gid = wgid / nig, fm = gid * wgm, gsz = (nM - fm) < wgm ? (nM - fm) : wgm;
        u.pm = fm + ((wgid % nig) % gsz); u.pn = (wgid % nig) / gsz; return true;
    }
    __device__ __forceinline__ void a_ready(const Unit&) const {}
    __device__ __forceinline__ void done(const Unit&) const {}
};

__device__ __forceinline__ unsigned cvt_pk_bf16(float lo, float hi) { unsigned r; asm volatile("v_cvt_pk_bf16_f32 %0, %1, %2" : "=v"(r) : "v"(lo), "v"(hi)); return r; }
typedef float f32x2 __attribute__((ext_vector_type(2)));
__device__ __forceinline__ f32x2 gelu_pk(f32x2 v) {
    const f32x2 av = __builtin_elementwise_abs(v), d = av * 0.2316418882f + 1.0f;
    f32x2 t; t.x = __builtin_amdgcn_rcpf(d.x); t.y = __builtin_amdgcn_rcpf(d.y);
    f32x2 q = t * 0.5307027145f + (-0.7265760135f); q = q * t + 0.7107068705f; q = q * t + (-0.142248368f); q = q * t + 0.127414796f; q = q * t;
    const f32x2 s = (v * v) * (-0.72134752044f);
    f32x2 e; e.x = __builtin_amdgcn_exp2f(s.x); e.y = __builtin_amdgcn_exp2f(s.y);
    const f32x2 m = v * (q * e), r = v - m;
    f32x2 o; o.x = v.x < 0.f ? m.x : r.x; o.y = v.y < 0.f ? m.y : r.y; return o;
}

typedef unsigned u32x2 __attribute__((ext_vector_type(2)));
struct EpiIn {
    static constexpr bool PERM = true, AFTER_DRAIN = false, MIDK = false;
    bf16_t *Q, *K, *V, *U; const float* rcos; const float* rsin; float qscale;
    __device__ __forceinline__ void operator()(const f32x4 (&acc)[2][2][4][2], const Unit& u, int wr, int wc, int fr, int fq) const {
        const int row0 = u.pm * BM + wr * 64 + fr, tile = u.pn, cw = wc * 32 + 8 * fq;
        if (tile < 9) {
            bf16_t* dst = tile < 8 ? Q + tile * 256 : K; const int ldc = tile < 8 ? 2048 : 256; const float sc = tile < 8 ? qscale : 1.0f;
            const int f0 = 4 * (4 * (wc & 1) + fq);
#pragma unroll
            for (int ai = 0; ai < 2; ++ai)
#pragma unroll
                for (int m = 0; m < 4; ++m) { const int row = row0 + ai * HALF + m * 16, pos = row & 4095;
                    const f32x4 cs = *(const f32x4*)(rcos + pos * 32 + f0) * sc, sn = *(const f32x4*)(rsin + pos * 32 + f0) * sc;
                    bf16_t* rowp = dst + (size_t)row * ldc + cw;
#pragma unroll
                    for (int bj = 0; bj < 2; ++bj) { const f32x4 x1 = acc[ai][bj][m][0], x2 = acc[ai][bj][m][1];
                        const f32x4 o1 = x1 * cs - x2 * sn, o2 = x2 * cs + x1 * sn;
                        u32x4 w; w.x = cvt_pk_bf16(o1[0], o1[1]); w.y = cvt_pk_bf16(o1[2], o1[3]); w.z = cvt_pk_bf16(o2[0], o2[1]); w.w = cvt_pk_bf16(o2[2], o2[3]);
                        *(u32x4*)(rowp + bj * HALF) = w; } }
        } else {
            bf16_t* dst = tile == 9 ? V : U + (tile - 10) * 256; const int ldc = tile == 9 ? 256 : 2048;
#pragma unroll
            for (int ai = 0; ai < 2; ++ai)
#pragma unroll
                for (int m = 0; m < 4; ++m) { bf16_t* rowp = dst + (size_t)(row0 + ai * HALF + m * 16) * ldc + cw;
#pragma unroll
                    for (int bj = 0; bj < 2; ++bj) { const f32x4 v0 = acc[ai][bj][m][0], v1 = acc[ai][bj][m][1];
                        u32x4 w; w.x = cvt_pk_bf16(v0[0], v0[1]); w.y = cvt_pk_bf16(v0[2], v0[3]); w.z = cvt_pk_bf16(v1[0], v1[1]); w.w = cvt_pk_bf16(v1[2], v1[3]);
                        *(u32x4*)(rowp + bj * HALF) = w; } }
        }
    }
};
__device__ __forceinline__ float bf_lo(unsigned w) { return __builtin_bit_cast(float, w << 16); }
__device__ __forceinline__ float bf_hi(unsigned w) { return __builtin_bit_cast(float, w & 0xffff0000u); }
struct EpiGlu {
    static constexpr bool PERM = true, AFTER_DRAIN = false, MIDK = false;
    const bf16_t* YG; const float* bias; bf16_t* O; float* SS;
    __device__ __forceinline__ void operator()(const f32x4 (&acc)[2][2][4][2], const Unit& u, int wr, int wc, int fr, int fq) const {
        const int row0 = u.pm * BM + wr * 64 + fr, col0 = u.pn * BM + wc * 32 + 8 * fq;
        f32x4 bv[2][2];
#pragma unroll
        for (int bj = 0; bj < 2; ++bj)
#pragma unroll
            for (int n = 0; n < 2; ++n) bv[bj][n] = *(const f32x4*)(bias + col0 + bj * HALF + 4 * n);
#pragma unroll
        for (int ai = 0; ai < 2; ++ai)
#pragma unroll
            for (int m = 0; m < 4; ++m) { const int row = row0 + ai * HALF + m * 16; float ss = 0.f;
#pragma unroll
                for (int bj = 0; bj < 2; ++bj) { const u32x4 yw = *(const u32x4*)(YG + (size_t)row * 2048 + col0 + bj * HALF);
                    const f32x4 z0 = acc[ai][bj][m][0] + bv[bj][0], z1 = acc[ai][bj][m][1] + bv[bj][1];
                    float o[8]; const float y[8] = {bf_lo(yw.x), bf_hi(yw.x), bf_lo(yw.y), bf_hi(yw.y), bf_lo(yw.z), bf_hi(yw.z), bf_lo(yw.w), bf_hi(yw.w)};
#pragma unroll
                    for (int e = 0; e < 4; ++e) { o[e] = y[e] * __builtin_amdgcn_rcpf(1.0f + __builtin_amdgcn_exp2f(-1.4426950408889634f * z0[e]));
                                                  o[4 + e] = y[4 + e] * __builtin_amdgcn_rcpf(1.0f + __builtin_amdgcn_exp2f(-1.4426950408889634f * z1[e])); }
#pragma unroll
                    for (int e = 0; e < 8; ++e) ss += o[e] * o[e];
                    u32x4 w; w.x = cvt_pk_bf16(o[0], o[1]); w.y = cvt_pk_bf16(o[2], o[3]); w.z = cvt_pk_bf16(o[4], o[5]); w.w = cvt_pk_bf16(o[6], o[7]);
                    *(u32x4*)(O + (size_t)row * 4096 + 2048 + col0 + bj * HALF) = w; }
                ss += __shfl_xor(ss, 16); ss += __shfl_xor(ss, 32);
                if (fq == 0) SS[(size_t)row * 32 + u.pn * 4 + wc] = ss; }
    }
};
struct EpiRes {
    static constexpr bool PERM = false, AFTER_DRAIN = false, MIDK = false;
    const float* base; float* out; const float* gate;
    __device__ __forceinline__ void operator()(const f32x4 (&acc)[2][2][4][2], const Unit& u, int wr, int wc, int fr, int fq) const {
        const int row0 = u.pm * BM + wr * 64 + fr, col0 = u.pn * BM + wc * 32 + 4 * fq; const float* gp = gate + (size_t)((u.pm * BM) >> 12) * 24576 + col0;
        f32x4 gv[2][2];
#pragma unroll
        for (int bj = 0; bj < 2; ++bj)
#pragma unroll
            for (int n = 0; n < 2; ++n) gv[bj][n] = *(const f32x4*)(gp + bj * HALF + n * 16);
#pragma unroll
        for (int ai = 0; ai < 2; ++ai)
#pragma unroll
            for (int m = 0; m < 4; ++m) { const size_t off = (size_t)(row0 + ai * HALF + m * 16) * 4096 + col0;
#pragma unroll
                for (int bj = 0; bj < 2; ++bj)
#pragma unroll
                    for (int n = 0; n < 2; ++n) { const f32x4 b = *(const f32x4*)(base + off + bj * HALF + n * 16); *(f32x4*)(out + off + bj * HALF + n * 16) = b + gv[bj][n] * acc[ai][bj][m][n]; } }
    }
};
struct EpiResMix {
    static constexpr bool PERM = false, AFTER_DRAIN = false, MIDK = true;
    const float* base; float* out; const float* gate; const PG8_LAS float* rat; const PG8_LAS float* rsc;
    __device__ __forceinline__ void midk(f32x4 (&acc)[2][2][4][2], int wr, int fr) const {
#pragma unroll
        for (int ai = 0; ai < 2; ++ai)
#pragma unroll
            for (int m = 0; m < 4; ++m) { const float r = rat[ai * HALF + wr * 64 + m * 16 + fr];
#pragma unroll
                for (int bj = 0; bj < 2; ++bj)
#pragma unroll
                    for (int n = 0; n < 2; ++n) acc[ai][bj][m][n] *= r; }
    }
    __device__ __forceinline__ void operator()(const f32x4 (&acc)[2][2][4][2], const Unit& u, int wr, int wc, int fr, int fq) const {
        const int row0 = u.pm * BM + wr * 64 + fr, col0 = u.pn * BM + wc * 32 + 4 * fq; const float* gp = gate + (size_t)((u.pm * BM) >> 12) * 24576 + col0;
        f32x4 gv[2][2];
#pragma unroll
        for (int bj = 0; bj < 2; ++bj)
#pragma unroll
            for (int n = 0; n < 2; ++n) gv[bj][n] = *(const f32x4*)(gp + bj * HALF + n * 16);
#pragma unroll
        for (int ai = 0; ai < 2; ++ai)
#pragma unroll
            for (int m = 0; m < 4; ++m) { const size_t off = (size_t)(row0 + ai * HALF + m * 16) * 4096 + col0; const float rs = rsc[ai * HALF + wr * 64 + m * 16 + fr];
#pragma unroll
                for (int bj = 0; bj < 2; ++bj)
#pragma unroll
                    for (int n = 0; n < 2; ++n) { const f32x4 b = *(const f32x4*)(base + off + bj * HALF + n * 16); *(f32x4*)(out + off + bj * HALF + n * 16) = b + gv[bj][n] * (acc[ai][bj][m][n] * rs); } }
    }
};
struct EpiSqRelu {
    static constexpr bool PERM = true, AFTER_DRAIN = false, MIDK = false;
    bf16_t* O; int ldc;
    __device__ __forceinline__ void operator()(const f32x4 (&acc)[2][2][4][2], const Unit& u, int wr, int wc, int fr, int fq) const {
        const int row0 = u.pm * BM + wr * 64 + fr, col0 = u.pn * BM + wc * 32 + 8 * fq;
#pragma unroll
        for (int ai = 0; ai < 2; ++ai)
#pragma unroll
            for (int m = 0; m < 4; ++m) { bf16_t* rowp = O + (size_t)(row0 + ai * HALF + m * 16) * ldc + col0;
#pragma unroll
                for (int bj = 0; bj < 2; ++bj) { f32x4 v0 = acc[ai][bj][m][0], v1 = acc[ai][bj][m][1];
#pragma unroll
                    for (int e = 0; e < 4; ++e) { const float a = fmaxf(v0[e], 0.f), b = fmaxf(v1[e], 0.f); v0[e] = a * a; v1[e] = b * b; }
                    u32x4 w; w.x = cvt_pk_bf16(v0[0], v0[1]); w.y = cvt_pk_bf16(v0[2], v0[3]); w.z = cvt_pk_bf16(v1[0], v1[1]); w.w = cvt_pk_bf16(v1[2], v1[3]);
                    *(u32x4*)(rowp + bj * HALF) = w; } }
    }
};

template <class Epi, class Sched, bool ALIGN_EPI = false, bool SP2 = false>
__device__ __forceinline__ void gemm_phase(PG8_LAS unsigned char* lds, const Gemm g, const Sched& S, const Epi& E) {
    const int tid = threadIdx.x, wid = __builtin_amdgcn_readfirstlane(tid >> 6), lane = tid & 63, wr = wid >> 2, wc = wid & 3, fr = lane & 15, fq = lane >> 4;
    const int K = g.K, nt = K / BK;
    unsigned voffA[2], voffB[2];
#pragma unroll
    for (int i = 0; i < 2; ++i) { int R, C; stage_rc(tid * 16 + i * 8192, R, C); const int Rb = Epi::PERM ? ((R & ~31) + perm32(R & 31)) : R;
        voffA[i] = (unsigned)(R * K + C) * 2u; voffB[i] = (unsigned)(Rb * K + C) * 2u; }
    const size_t kstep = (size_t)(BK * 2);
    const size_t hstep = (size_t)HALF * K * 2;
    const size_t tstep = 2 * hstep;
    const unsigned ldsw = (unsigned)wid * 1024u;
    const int aoff = lds_byte(wr * 64 + fr, fq * 8), boff = lds_byte(wc * 32 + fr, fq * 8);
#define PG8_SA(b, h) (((b) * 2 + (h)) * HTB)
#define PG8_SB(b, h) ((4 + (b) * 2 + (h)) * HTB)
#define PG8_STAGE(bufoff, gbase, voff) do { _Pragma("unroll") for (int _i = 0; _i < 2; ++_i) \
        __builtin_amdgcn_global_load_lds((const unsigned*)((const char*)(gbase) + (voff)[_i]), (PG8_LAS unsigned*)(lds + (bufoff) + ldsw + _i * 8192), 16, 0, 0); } while (0)
#define PG8_LDA(dst, b, h) do { _Pragma("unroll") for (int m = 0; m < 4; ++m) _Pragma("unroll") for (int k = 0; k < 2; ++k) dst[m][k] = *(const PG8_LAS bf16x8*)(lds + PG8_SA(b, h) + aoff + m * 2048 + k * 1024); } while (0)
#define PG8_LDB(dst, b, h) do { _Pragma("unroll") for (int n = 0; n < 2; ++n) _Pragma("unroll") for (int k = 0; k < 2; ++k) dst[n][k] = *(const PG8_LAS bf16x8*)(lds + PG8_SB(b, h) + boff + n * 2048 + k * 1024); } while (0)
#define PG8_MMA(ai, bj, At, Bt) do { __builtin_amdgcn_s_setprio(1); _Pragma("unroll") for (int m = 0; m < 4; ++m) _Pragma("unroll") for (int n = 0; n < 2; ++n) _Pragma("unroll") for (int k = 0; k < 2; ++k) \
        acc[ai][bj][m][n] = __builtin_amdgcn_mfma_f32_16x16x32_bf16(Bt[n][k], At[m][k], acc[ai][bj][m][n], 0, 0, 0); __builtin_amdgcn_s_setprio(0); } while (0)
#define PG8_WAIT_V(n) asm volatile("s_waitcnt vmcnt(" #n ")" ::: "memory")
#define PG8_WAIT_L(n) asm volatile("s_waitcnt lgkmcnt(" #n ")" ::: "memory")
#define PG8_BAR __builtin_amdgcn_s_barrier()
#define PG8_SCHED __builtin_amdgcn_sched_barrier(0)
    Unit cur, nxt; int ui = 0;
    if (!S.next(0, cur)) return;
    f32x4 acc[2][2][4][2];
#pragma unroll
    for (int a = 0; a < 2; ++a)
#pragma unroll
        for (int b = 0; b < 2; ++b)
#pragma unroll
            for (int m = 0; m < 4; ++m)
#pragma unroll
                for (int n = 0; n < 2; ++n) acc[a][b][m][n] = (f32x4){0.f, 0.f, 0.f, 0.f};
    bf16x8 At[4][2], B0[2][2], B1[2][2];
    const char* cA = (const char*)g.A + (size_t)cur.pm * tstep; const char* cB = (const char*)g.Bt + (size_t)cur.pn * tstep;
    S.a_ready(cur);
    if constexpr (SP2) {
        PG8_STAGE(PG8_SB(0, 0), cB, voffB); PG8_STAGE(PG8_SB(0, 1), cB + hstep, voffB); PG8_STAGE(PG8_SA(0, 0), cA, voffA); PG8_STAGE(PG8_SA(0, 1), cA + hstep, voffA);
        if (wr == 1) PG8_BAR;
        PG8_WAIT_V(2); PG8_BAR;
        PG8_STAGE(PG8_SB(1, 0), cB + kstep, voffB); PG8_STAGE(PG8_SA(1, 0), cA + kstep, voffA); PG8_STAGE(PG8_SB(1, 1), cB + hstep + kstep, voffB);
        PG8_WAIT_V(6); PG8_BAR;
    } else {
        PG8_STAGE(PG8_SB(0, 0), cB, voffB); PG8_STAGE(PG8_SA(0, 0), cA, voffA); PG8_STAGE(PG8_SB(0, 1), cB + hstep, voffB); PG8_STAGE(PG8_SA(0, 1), cA + hstep, voffA);
        if (wr == 1) PG8_BAR;
        PG8_WAIT_V(4); PG8_BAR;
        PG8_STAGE(PG8_SB(1, 0), cB + kstep, voffB); PG8_STAGE(PG8_SA(1, 0), cA + kstep, voffA); PG8_STAGE(PG8_SB(1, 1), cB + hstep + kstep, voffB);
        PG8_WAIT_V(6); PG8_BAR;
    }
    for (;;) {
        const bool has_next = S.next(ui + 1, nxt);
        const char* nA = has_next ? (const char*)g.A + (size_t)nxt.pm * tstep : cA; const char* nB = has_next ? (const char*)g.Bt + (size_t)nxt.pn * tstep : cB;
        for (int t = 0; t < nt; t += 2) {
            const bool last = (t == nt - 2);
            if constexpr (Epi::MIDK) { if (t == (nt >> 1)) E.midk(acc, wr, fr); }
            const char* a1 = cA + (size_t)(t + 1) * kstep;
            const char* a2 = last ? nA : cA + (size_t)(t + 2) * kstep; const char* b2 = last ? nB : cB + (size_t)(t + 2) * kstep;
            const char* a3 = a2 + kstep; const char* b3 = b2 + kstep;
            if (last && has_next) S.a_ready(nxt);
            if constexpr (SP2) {
            PG8_LDB(B0, 0, 0); PG8_LDB(B1, 0, 1); PG8_SCHED; PG8_LDA(At, 0, 0); PG8_STAGE(PG8_SA(1, 1), a1 + hstep, voffA);
            PG8_WAIT_V(8); PG8_WAIT_L(0); PG8_BAR; PG8_MMA(0, 0, At, B0); PG8_MMA(0, 1, At, B1); PG8_BAR; PG8_SCHED;
            PG8_LDA(At, 0, 1); PG8_STAGE(PG8_SB(0, 0), b2, voffB); PG8_STAGE(PG8_SB(0, 1), b2 + hstep, voffB); PG8_STAGE(PG8_SA(0, 0), a2, voffA);
            PG8_WAIT_V(8); PG8_WAIT_L(0); PG8_BAR; PG8_MMA(1, 0, At, B0); PG8_MMA(1, 1, At, B1); PG8_BAR; PG8_SCHED;
            PG8_LDB(B0, 1, 0); PG8_LDB(B1, 1, 1); PG8_SCHED; PG8_LDA(At, 1, 0); PG8_STAGE(PG8_SA(0, 1), a2 + hstep, voffA);
            PG8_WAIT_V(8); PG8_WAIT_L(0); PG8_BAR; PG8_MMA(0, 0, At, B0); PG8_MMA(0, 1, At, B1); PG8_BAR; PG8_SCHED;
            PG8_LDA(At, 1, 1); PG8_STAGE(PG8_SB(1, 0), b3, voffB); PG8_STAGE(PG8_SB(1, 1), b3 + hstep, voffB); PG8_STAGE(PG8_SA(1, 0), a3, voffA);
            PG8_WAIT_V(8); PG8_WAIT_L(0); PG8_BAR; PG8_MMA(1, 0, At, B0); PG8_MMA(1, 1, At, B1); PG8_BAR; PG8_SCHED;
            } else {
            PG8_LDB(B0, 0, 0); PG8_SCHED; PG8_LDA(At, 0, 0); PG8_STAGE(PG8_SA(1, 1), a1 + hstep, voffA);
            PG8_WAIT_L(8); PG8_BAR; PG8_WAIT_L(0); PG8_MMA(0, 0, At, B0); PG8_BAR; PG8_SCHED;
            PG8_LDB(B1, 0, 1); PG8_STAGE(PG8_SB(0, 0), b2, voffB);
            PG8_BAR; PG8_WAIT_L(0); PG8_MMA(0, 1, At, B1); PG8_BAR;
            PG8_LDA(At, 0, 1); PG8_STAGE(PG8_SA(0, 0), a2, voffA);
            PG8_BAR; PG8_WAIT_L(0); PG8_MMA(1, 0, At, B0); PG8_BAR; PG8_SCHED;
            PG8_STAGE(PG8_SB(0, 1), b2 + hstep, voffB);
            PG8_WAIT_V(6); PG8_BAR; PG8_MMA(1, 1, At, B1); PG8_BAR;
            PG8_LDB(B0, 1, 0); PG8_SCHED; PG8_LDA(At, 1, 0); PG8_STAGE(PG8_SA(0, 1), a2 + hstep, voffA);
            PG8_WAIT_L(8); PG8_BAR; PG8_WAIT_L(0); PG8_MMA(0, 0, At, B0); PG8_BAR; PG8_SCHED;
            PG8_LDB(B1, 1, 1); PG8_STAGE(PG8_SB(1, 0), b3, voffB);
            PG8_BAR; PG8_WAIT_L(0); PG8_MMA(0, 1, At, B1); PG8_BAR;
            PG8_LDA(At, 1, 1); PG8_STAGE(PG8_SA(1, 0), a3, voffA);
            PG8_BAR; PG8_WAIT_L(0); PG8_MMA(1, 0, At, B0); PG8_BAR; PG8_SCHED;
            PG8_STAGE(PG8_SB(1, 1), b3 + hstep, voffB);
            PG8_WAIT_V(6); PG8_BAR; PG8_MMA(1, 1, At, B1); PG8_BAR;
            }
        }
        if constexpr (ALIGN_EPI) { if (wr == 0) PG8_BAR; }
        if constexpr (!Epi::AFTER_DRAIN) { E(acc, cur, wr, wc, fr, fq); S.done(cur); }
        if (!has_next) break;
#pragma unroll
        for (int a = 0; a < 2; ++a)
#pragma unroll
            for (int b = 0; b < 2; ++b)
#pragma unroll
                for (int m = 0; m < 4; ++m)
#pragma unroll
                    for (int n = 0; n < 2; ++n) acc[a][b][m][n] = (f32x4){0.f, 0.f, 0.f, 0.f};
        cur = nxt; cA = nA; cB = nB; ++ui;
        if constexpr (ALIGN_EPI) { if (wr == 1) PG8_BAR; }
    }
    PG8_WAIT_V(0);
    if constexpr (!ALIGN_EPI) { if (wr == 0) PG8_BAR; }
    PG8_BAR;
    if constexpr (Epi::AFTER_DRAIN) { E.fused(acc, cur, wr, wc, fr, fq, lds, wid, lane); S.done(cur); }
#undef PG8_SA
#undef PG8_SB
#undef PG8_STAGE
#undef PG8_LDA
#undef PG8_LDB
#undef PG8_MMA
#undef PG8_WAIT_V
#undef PG8_WAIT_L
#undef PG8_BAR
#undef PG8_SCHED
}
}
constexpr int NWAVES = 8;
constexpr int BATCH = 4, SEQ = 4096, DM = 4096, M = BATCH * SEQ;
constexpr int D_ATTN = 2048, D_KV = 256, D_SSM = 2048, D_IN = 4608, D_FF = 16384, NMODC = 6 * DM;
constexpr float EPS = 1e-6f, LOG2E = 1.4426950408889634f;
constexpr size_t MiB = 1u << 20;
constexpr size_t WS_CTL = 0, CTL_ZERO_BYTES = 2 * MiB;
constexpr size_t WS_MOD = 1 * MiB;
constexpr size_t WS_ROPE = 2 * MiB;
constexpr size_t WS_SSA = 4 * MiB, WS_SSS = 6 * MiB;
constexpr size_t WS_WIN = 8 * MiB, WS_WGLU = 44 * MiB, WS_WOUT = 52 * MiB, WS_WFF1 = 84 * MiB, WS_WFF2 = 212 * MiB;
constexpr size_t WS_H = 340 * MiB;
constexpr size_t WS_Q = 468 * MiB, WS_K = 532 * MiB, WS_V = 540 * MiB, WS_U = 548 * MiB;
constexpr size_t WS_MIX = 612 * MiB;
constexpr size_t WS_YG = 740 * MiB;
constexpr size_t WS_HID = 804 * MiB;
constexpr size_t WS_END = 1316 * MiB;
constexpr int CW_BAR = 4096;
constexpr int RING_OFF = 0, RING_BYTES = 131072;
constexpr int LDSCTL_OFF = RING_BYTES, MISC_OFF = LDSCTL_OFF + 320;
constexpr int LDS_BYTES = 147456;
#ifndef WGM_IN
#define WGM_IN 8
#endif
#ifndef WGM_GLU
#define WGM_GLU 8
#endif
#ifndef WGM_OUT
#define WGM_OUT 8
#endif
#ifndef WGM_FF1
#define WGM_FF1 8
#endif
#ifndef WGM_FF2
#define WGM_FF2 8
#endif

#define GAS __attribute__((address_space(1)))
#define LAS __attribute__((address_space(3)))
typedef unsigned short bf16;
typedef unsigned v4u __attribute__((ext_vector_type(4)));
typedef float f32x4 __attribute__((ext_vector_type(4)));
typedef short bf16x8 __attribute__((ext_vector_type(8)));
typedef GAS unsigned gu32;
typedef GAS unsigned long long gu64;
#define RLX_AGENT __ATOMIC_RELAXED, __HIP_MEMORY_SCOPE_AGENT
#define LDS_WAIT() asm volatile("s_waitcnt lgkmcnt(0)" ::: "memory")
#define VM_WAIT() asm volatile("s_waitcnt vmcnt(0)" ::: "memory")
__device__ __forceinline__ unsigned long long rt() { return __builtin_amdgcn_s_memrealtime(); }
__device__ __forceinline__ unsigned f2bf(float f) { unsigned u = __builtin_bit_cast(unsigned, f); return (u + 0x7fffu + ((u >> 16) & 1u)) >> 16; }
__device__ __forceinline__ unsigned pk2(float lo, float hi) { return f2bf(lo) | (f2bf(hi) << 16); }

#define XB_TMO      128
#define XB_XCNT(j)  (256  + 64 * (j))
#define XB_XSUB(j)  (1280 + 64 * (j))
#define XB_XGEN(j)  (2304 + 64 * (j))
#define XB_TOP      3328
#define XB_TOPGEN   3392
#define XCD_BAR_WORDS 3456
#define XB_SPIN_CAP (1u << 21)

__device__ __forceinline__ unsigned xb_ld(unsigned* p)              { return __hip_atomic_load(p, __ATOMIC_RELAXED, __HIP_MEMORY_SCOPE_AGENT); }
__device__ __forceinline__ unsigned xb_add(unsigned* p, unsigned v) { return __hip_atomic_fetch_add(p, v, __ATOMIC_RELAXED, __HIP_MEMORY_SCOPE_AGENT); }
__device__ __forceinline__ unsigned xb_xcc_id() { return (unsigned)__builtin_amdgcn_s_getreg((3 << 11) | 20) & 0xFu; }
#define XB_SPIN(cond, bar) do { unsigned _sp = 0; while (cond) { __builtin_amdgcn_s_sleep(1); \
    if ((++_sp & 255u) == 0u) { if (xb_ld(&(bar)[XB_TMO])) break; if (_sp > XB_SPIN_CAP) { atomicAdd(&(bar)[XB_TMO], 1u); break; } } } } while (0)

struct XcdBarrier {
    unsigned* bar; unsigned x;
    volatile LAS unsigned* st;
};

__device__ __forceinline__ XcdBarrier xcd_barrier_post(unsigned* bar, volatile LAS unsigned* st) {
    XcdBarrier b; b.bar = bar; b.x = xb_xcc_id(); b.st = st;
    if (threadIdx.x == 0) (void)xb_add(&bar[XB_XCNT(b.x)], 1u);
    return b;
}
__device__ __forceinline__ void xcd_barrier_complete(unsigned* bar, unsigned x, unsigned& nloc, unsigned& nx) {
    const unsigned G = gridDim.x * gridDim.y * gridDim.z;
    unsigned sum, cnt, mine, sp = 0u;
    for (;;) {
        sum = 0u; cnt = 0u; mine = 0u;
#pragma unroll
        for (unsigned j = 0; j < 16; ++j) { const unsigned c = xb_ld(&bar[XB_XCNT(j)]); sum += c; cnt += (c > 0u) ? 1u : 0u; mine = (j == x) ? c : mine; }
        if (sum == G) break;
        __builtin_amdgcn_s_sleep(1);
        if ((++sp & 255u) == 0u) { if (xb_ld(&bar[XB_TMO])) break; if (sp > XB_SPIN_CAP) { atomicAdd(&bar[XB_TMO], 1u); break; } }
    }
    nloc = mine > 0u ? mine : 1u; nx = cnt > 0u ? cnt : 1u;
}

__device__ __forceinline__ void xcd_barrier(const XcdBarrier& b) {
    asm volatile("s_waitcnt vmcnt(0)" ::: "memory");
    __syncthreads();
    if (threadIdx.x == 0) {
        unsigned* bar = b.bar;
        __builtin_amdgcn_s_waitcnt(0);
        unsigned nloc = b.st[0], nx = b.st[1];
        if (nloc == 0u) { xcd_barrier_complete(bar, b.x, nloc, nx); b.st[0] = nloc; b.st[1] = nx; }
        const unsigned old = xb_add(&bar[XB_XSUB(b.x)], 1u);
        const unsigned gen = old / nloc;
        if (old + 1u == (gen + 1u) * nloc) {
            __builtin_amdgcn_fence(__ATOMIC_RELEASE, "agent");
            asm volatile("s_waitcnt vmcnt(0)" ::: "memory");
            const unsigned og = xb_add(&bar[XB_TOP], 1u);
            const unsigned tg = og / nx;
            if (og + 1u == (tg + 1u) * nx) xb_add(&bar[XB_TOPGEN], 1u);
            else XB_SPIN(xb_ld(&bar[XB_TOPGEN]) == tg, bar);
            __builtin_amdgcn_fence(__ATOMIC_ACQUIRE, "agent");
            xb_add(&bar[XB_XGEN(b.x)], 1u);
            asm volatile("s_waitcnt vmcnt(0)" ::: "memory");
        } else {
            XB_SPIN(xb_ld(&bar[XB_XGEN(b.x)]) == gen, bar);
            __builtin_amdgcn_fence(__ATOMIC_ACQUIRE, "agent");
            asm volatile("s_waitcnt vmcnt(0)" ::: "memory");
        }
    }
    __syncthreads();
}


struct Frame {
    LAS unsigned char* lds;
    volatile LAS unsigned* MISC;
    gu32* ctl;
    int tid, lane, wave;
    int vcu, G;
};
__device__ __forceinline__ float wave_sum(float v) {
#pragma unroll
    for (int o = 1; o < 64; o <<= 1) v += __shfl_xor(v, o);
    return v;
}
__device__ __forceinline__ float wave_max(float v) {
#pragma unroll
    for (int o = 1; o < 64; o <<= 1) v = fmaxf(v, __shfl_xor(v, o));
    return v;
}
__device__ __forceinline__ float bf2f(unsigned short h) { return __builtin_bit_cast(float, (unsigned)h << 16); }
__device__ __forceinline__ float bflo(unsigned w) { return __builtin_bit_cast(float, w << 16); }
__device__ __forceinline__ float bfhi(unsigned w) { return __builtin_bit_cast(float, w & 0xffff0000u); }
__device__ __forceinline__ void dsincos(double x, float& s, float& c) {
    const double k = __builtin_rint(x * 0.63661977236758134308);
    double r = __builtin_fma(-k, 1.57079632679489655800e+00, x); r = __builtin_fma(-k, 6.12323399573676603587e-17, r);
    const double r2 = r * r;
    double sp = -7.6471637318198164759e-13; sp = sp * r2 + 1.6059043836821614599e-10; sp = sp * r2 - 2.5052108385441718775e-08; sp = sp * r2 + 2.7557319223985890653e-06;
    sp = sp * r2 - 1.9841269841269841270e-04; sp = sp * r2 + 8.3333333333333333333e-03; sp = sp * r2 - 1.6666666666666666667e-01; sp = r + r * r2 * sp;
    double cp = 4.7794773323873852974e-14; cp = cp * r2 - 1.1470745597729724714e-11; cp = cp * r2 + 2.0876756987868098979e-09; cp = cp * r2 - 2.7557319223985890653e-07;
    cp = cp * r2 + 2.4801587301587301587e-05; cp = cp * r2 - 1.3888888888888888889e-03; cp = cp * r2 + 4.1666666666666666667e-02; cp = cp * r2 - 0.5; cp = 1.0 + r2 * cp;
    const int q = (int)((long long)k & 3);
    const double ss = (q & 1) ? cp : sp, cc = (q & 1) ? sp : cp;
    s = (float)((q & 2) ? -ss : ss); c = (float)(((q + 1) & 2) ? -cc : cc);
}

struct TrTile { f32x4 v[16]; };
template <int MODE> __device__ __forceinline__ void tr_load(TrTile& t, const float* W, int N, int tile, int lane, const float* gk) {
    const int nblk = N / 64, k0 = 64 * (tile / nblk), n0 = 64 * (tile % nblk), r4 = lane >> 4, c16 = lane & 15;
    const GAS float* p = (const GAS float*)W + (size_t)(k0 + 2 * r4) * N + n0 + 4 * c16;
#pragma unroll
    for (int i = 0; i < 8; ++i) { t.v[2 * i] = *(const GAS f32x4*)(p + (size_t)(8 * i) * N); t.v[2 * i + 1] = *(const GAS f32x4*)(p + (size_t)(8 * i + 1) * N); }
    if (MODE == 2) {
#pragma unroll
        for (int i = 0; i < 8; ++i) { t.v[2 * i] *= gk[k0 + 8 * i + 2 * r4]; t.v[2 * i + 1] *= gk[k0 + 8 * i + 2 * r4 + 1]; } }
}
template <int MODE> __device__ __forceinline__ void tr_store(const TrTile& t, int K, int N, bf16* WT, LAS unsigned* T, int tile, int lane) {
    const int nblk = N / 64, k0 = 64 * (tile / nblk), n0 = 64 * (tile % nblk), r4 = lane >> 4, c16 = lane & 15;
#pragma unroll
    for (int i = 0; i < 8; ++i) { const int kp = 4 * i + r4;
#pragma unroll
        for (int e = 0; e < 4; ++e) T[(4 * c16 + e) * 33 + kp] = pg8::cvt_pk_bf16(t.v[2 * i][e], t.v[2 * i + 1][e]); }
    LDS_WAIT(); asm volatile("" ::: "memory");
    const int c = lane & 7, n8 = lane >> 3;
#pragma unroll
    for (int j = 0; j < 8; ++j) { const int n = n8 + 8 * j; const LAS unsigned* s = T + n * 33 + 4 * c;
        v4u o; o.x = s[0]; o.y = s[1]; o.z = s[2]; o.w = s[3];
        int drow = n0 + n;
        if (MODE == 1 && drow < D_ATTN + D_KV) { const int d = drow & 63; drow = (drow & ~63) + 8 * ((d & 31) >> 2) + 4 * (d >> 5) + (d & 3); }
        *(GAS v4u*)(WT + (size_t)drow * K + k0 + 8 * c) = o; }
    LDS_WAIT(); asm volatile("" ::: "memory");
}
template <int MODE> __device__ __forceinline__ void tr_range(const float* W, int K, int N, bf16* WT, LAS unsigned* T, int first, int last, int w0, int nw, int lane, const float* ga, const float* gs) {
    int tile = first + w0; if (tile >= last) return;
    TrTile cur, nxt;
    tr_load<MODE>(cur, W, N, tile, lane, (MODE == 2) ? ((64 * (tile / (N / 64)) < D_ATTN) ? ga : gs - D_ATTN) : nullptr);
    for (;;) {
        const int nt = tile + nw; const bool more = nt < last;
        if (more) tr_load<MODE>(nxt, W, N, nt, lane, (MODE == 2) ? ((64 * (nt / (N / 64)) < D_ATTN) ? ga : gs - D_ATTN) : nullptr);
        tr_store<MODE>(cur, K, N, WT, T, tile, lane);
        if (!more) break;
        cur = nxt; tile = nt;
    }
}
constexpr int T_IN = (DM / 64) * (D_IN / 64), T_GLU = (D_SSM / 64) * (D_SSM / 64), T_OUT = (DM / 64) * (DM / 64), T_F1 = (DM / 64) * (D_FF / 64), T_F2 = (D_FF / 64) * (DM / 64);
#ifndef SPARE_F1_TILES
#define SPARE_F1_TILES 0
#endif
constexpr int GEMM1_WGS = 232;
struct In { const float *x, *c, *w_ada, *b_ada, *norm1_g, *w_in, *sinks, *lam_re, *lam_im, *log_step, *b_re, *b_im, *c_re, *c_im, *ssm_d, *w_glu, *b_glu, *attn_g, *ssm_g, *w_out, *norm2_g, *w_ff1, *w_ff2, *final_g; };
__device__ __forceinline__ void p0_gemv(Frame& F, const In& I, float* mod) {
    LAS float* red = (LAS float*)(F.lds);
    const int lane = F.lane, w = F.wave;
    for (int item = F.vcu; item < 96 * 8; item += F.G) {
        const int nc = item % 96, kg = item / 96, n0 = nc * 256 + 4 * lane, k0 = kg * 512 + 64 * w;
        f32x4 acc[4]; float ca[4];
#pragma unroll
        for (int b = 0; b < 4; ++b) { acc[b] = (f32x4){0.f, 0.f, 0.f, 0.f}; const float cv = I.c[b * DM + k0 + lane]; ca[b] = cv / (1.0f + __expf(-cv)); }
        const GAS f32x4* wp = (const GAS f32x4*)(I.w_ada + (size_t)k0 * NMODC + n0);
#pragma unroll 16
        for (int kk = 0; kk < 64; ++kk) { const f32x4 wv = wp[(size_t)kk * (NMODC / 4)];
#pragma unroll
            for (int b = 0; b < 4; ++b) { const float cb = __builtin_bit_cast(float, __builtin_amdgcn_readlane(__builtin_bit_cast(int, ca[b]), kk)); acc[b] += cb * wv; } }
        __syncthreads();
#pragma unroll
        for (int b = 0; b < 4; ++b) *(LAS f32x4*)(red + (w * 4 + b) * 256 + 4 * lane) = acc[b];
        __syncthreads();
#pragma unroll
        for (int o = 0; o < 2; ++o) { const int idx = F.tid + 512 * o, b = idx >> 8, n = idx & 255; float s = 0.f;
#pragma unroll
            for (int ww = 0; ww < 8; ++ww) s += red[(ww * 4 + b) * 256 + n];
            if (kg == 0) s += I.b_ada[nc * 256 + n];
            unsafeAtomicAdd(mod + b * NMODC + nc * 256 + n, s); }
    }
    __syncthreads();
}
__device__ __forceinline__ void p0_prologue(Frame& F, const In& I, unsigned char* ws) {
    const int gw = F.vcu * NWAVES + F.wave, NGW = F.G * NWAVES;
    p0_gemv(F, I, (float*)(ws + WS_MOD));
    LAS unsigned* T = (LAS unsigned*)(F.lds + RING_OFF + F.wave * 8448);
    bf16 *win = (bf16*)(ws + WS_WIN), *wglu = (bf16*)(ws + WS_WGLU), *wout = (bf16*)(ws + WS_WOUT), *wff1 = (bf16*)(ws + WS_WFF1);
    tr_range<1>(I.w_in, DM, D_IN, win, T, 0, T_IN, gw, NGW, F.lane, nullptr, nullptr);
    tr_range<0>(I.w_glu, D_SSM, D_SSM, wglu, T, 0, T_GLU, (gw + T_IN) % NGW, NGW, F.lane, nullptr, nullptr);
    tr_range<2>(I.w_out, DM, DM, wout, T, 0, T_OUT, (gw + T_IN + T_GLU) % NGW, NGW, F.lane, I.attn_g, I.ssm_g);
    if (SPARE_F1_TILES < T_F1) tr_range<0>(I.w_ff1, DM, D_FF, wff1, T, SPARE_F1_TILES, T_F1, (gw + T_IN + T_GLU + T_OUT) % NGW, NGW, F.lane, nullptr, nullptr);
    float* rc = (float*)(ws + WS_ROPE); float* rs = rc + SEQ * 32;
    for (int idx = gw * 64 + F.lane; idx < SEQ * 32; idx += NGW * 64) { const int pos = idx >> 5, f = idx & 31;
        const float inv = exp2f(-(float)f * (13.287712379549449f / 32.0f)); const float ang = (float)pos * inv;
        float s, c; dsincos((double)ang, s, c); rc[idx] = c; rs[idx] = s; }
}
__device__ __forceinline__ void spare_convert(Frame& F, const In& I, unsigned char* ws, int sidx, int nspare) {
    LAS unsigned* T = (LAS unsigned*)(F.lds + RING_OFF + F.wave * 8448);
    const int w0 = sidx * NWAVES + F.wave, nw = nspare * NWAVES;
    tr_range<0>(I.w_ff2, D_FF, DM, (bf16*)(ws + WS_WFF2), T, 0, T_F2, w0, nw, F.lane, nullptr, nullptr);
    if (SPARE_F1_TILES > 0) tr_range<0>(I.w_ff1, DM, D_FF, (bf16*)(ws + WS_WFF1), T, 0, SPARE_F1_TILES, (w0 + T_F2) % nw, nw, F.lane, nullptr, nullptr);
}
__device__ __forceinline__ void norm_mod_row(const float* xrow, const float* g, const float* scale, const float* shift, bf16* orow, int lane) {
    const GAS f32x4* xr = (const GAS f32x4*)xrow + lane;
    f32x4 v[16]; float s = 0.f;
#pragma unroll
    for (int j = 0; j < 16; ++j) { v[j] = xr[64 * j]; s += (v[j].x * v[j].x + v[j].y * v[j].y) + (v[j].z * v[j].z + v[j].w * v[j].w); }
    const float r = 1.0f / sqrtf(wave_sum(s) * (1.0f / DM) + EPS);
    GAS unsigned long long* o8 = (GAS unsigned long long*)orow + lane;
#pragma unroll
    for (int j = 0; j < 16; ++j) { const f32x4 gg = ((const GAS f32x4*)g)[64 * j + lane], sc = ((const GAS f32x4*)scale)[64 * j + lane], sh = ((const GAS f32x4*)shift)[64 * j + lane];
        const f32x4 o = (v[j] * r) * gg * (sc + 1.0f) + sh;
        o8[64 * j] = (unsigned long long)pk2(o.x, o.y) | ((unsigned long long)pk2(o.z, o.w) << 32); }
}
__device__ __forceinline__ void final_norm_row(float* xrow, const float* g, int lane) {
    GAS f32x4* xr = (GAS f32x4*)xrow + lane;
    f32x4 v[16]; float s = 0.f;
#pragma unroll
    for (int j = 0; j < 16; ++j) { v[j] = xr[64 * j]; s += (v[j].x * v[j].x + v[j].y * v[j].y) + (v[j].z * v[j].z + v[j].w * v[j].w); }
    const float r = 1.0f / sqrtf(wave_sum(s) * (1.0f / DM) + EPS);
#pragma unroll
    for (int j = 0; j < 16; ++j) { const f32x4 gg = ((const GAS f32x4*)g)[64 * j + lane]; xr[64 * j] = (v[j] * r) * gg; }
}
__device__ __forceinline__ void mix_scale_row(bf16* mrow, const float* ssa, const float* sss, int lane) {
    float p = lane < 32 ? ssa[lane] : sss[lane - 32];
#pragma unroll
    for (int o = 1; o < 32; o <<= 1) p += __shfl_xor(p, o);
    const float rmine = 1.0f / sqrtf(p * (1.0f / 2048.0f) + EPS), rother = __shfl_xor(rmine, 32);
    const float ra = lane < 32 ? rmine : rother, rs = lane < 32 ? rother : rmine;
    GAS v4u* mp = (GAS v4u*)mrow + lane;
#pragma unroll
    for (int j = 0; j < 8; ++j) { v4u w = mp[64 * j]; const float r = j < 4 ? ra : rs;
        w.x = pk2(bflo(w.x) * r, bfhi(w.x) * r); w.y = pk2(bflo(w.y) * r, bfhi(w.y) * r); w.z = pk2(bflo(w.z) * r, bfhi(w.z) * r); w.w = pk2(bflo(w.w) * r, bfhi(w.w) * r);
        mp[64 * j] = w; }
}

__device__ __forceinline__ void attn_phase_simple(Frame& F, const bf16* Q, const bf16* K, const bf16* V, bf16* O, float* SSA, const float* sinks) {
    LAS unsigned* Ks = (LAS unsigned*)(F.lds);
    LAS unsigned short* Vs = (LAS unsigned short*)(F.lds + 33792);
    LAS float* wsc = (LAS float*)(F.lds + 33792 + 32768 + F.wave * 1024);
    const int lane = F.lane;
    for (int unit = F.vcu; unit < BATCH * 32 * 4; unit += F.G) {
        const int kvh = unit & 3, nb = (unit >> 2) & 31, b = unit >> 7;
        const size_t tok0 = (size_t)b * SEQ + nb * 128;
        __syncthreads();
        for (int c = F.tid; c < 2048; c += NWAVES * 64) { const int kk = c >> 3, ch = c & 7;
            v4u kv = (v4u){0u, 0u, 0u, 0u}, vv = (v4u){0u, 0u, 0u, 0u};
            if (nb > 0 || kk >= 128) { const size_t r = tok0 - 128 + kk; kv = *(const GAS v4u*)(K + r * D_KV + kvh * 64 + ch * 8); vv = *(const GAS v4u*)(V + r * D_KV + kvh * 64 + ch * 8); }
            LAS unsigned* kd = Ks + kk * 33 + ch * 4; kd[0] = kv.x; kd[1] = kv.y; kd[2] = kv.z; kd[3] = kv.w;
            *(LAS v4u*)(Vs + kk * 64 + ch * 8) = vv; }
        __syncthreads();
        const int hq = kvh * 8 + F.wave; const float sink2 = sinks[hq] * LOG2E;
        for (int i = 0; i < 128; ++i) {
            const size_t row = tok0 + i;
            wsc[lane] = bf2f(Q[row * D_ATTN + hq * 64 + lane]);
            f32x4 q4[16];
#pragma unroll
            for (int j = 0; j < 16; ++j) q4[j] = *(const LAS f32x4*)(wsc + 4 * j);
            const int kA = i + 1 + lane, kB = kA + 64;
            float sA = 0.f, sB = 0.f;
#pragma unroll
            for (int j = 0; j < 16; ++j) { const unsigned a0 = Ks[kA * 33 + 2 * j], a1 = Ks[kA * 33 + 2 * j + 1], b0 = Ks[kB * 33 + 2 * j], b1 = Ks[kB * 33 + 2 * j + 1];
                sA += q4[j].x * bflo(a0) + q4[j].y * bfhi(a0) + q4[j].z * bflo(a1) + q4[j].w * bfhi(a1);
                sB += q4[j].x * bflo(b0) + q4[j].y * bfhi(b0) + q4[j].z * bflo(b1) + q4[j].w * bfhi(b1); }
            if (nb == 0) { if (kA < 128) sA = -INFINITY; if (kB < 128) sB = -INFINITY; }
            const float mx = fmaxf(wave_max(fmaxf(sA, sB)), sink2);
            const float pA = exp2f(sA - mx), pB = exp2f(sB - mx);
            const float den = wave_sum(pA + pB) + exp2f(sink2 - mx);
            wsc[64 + lane] = pA; wsc[128 + lane] = pB;
            float o = 0.f;
#pragma unroll 8
            for (int l4 = 0; l4 < 32; ++l4) { const f32x4 p4 = *(const LAS f32x4*)(wsc + 64 + 4 * l4); const LAS unsigned short* vp = Vs + (i + 1 + 4 * l4) * 64 + lane;
                o += p4.x * bf2f(vp[0]) + p4.y * bf2f(vp[64]) + p4.z * bf2f(vp[128]) + p4.w * bf2f(vp[192]); }
            o = o / den;
            const unsigned ob = f2bf(o); const float of = bf2f((unsigned short)ob);
            const float ss = wave_sum(of * of);
            O[row * DM + hq * 64 + lane] = (bf16)ob;
            if (lane == 0) SSA[row * 32 + hq] = ss;
        }
    }
}

__device__ __forceinline__ float erf_gelu(float y) { return 0.5f * y * (1.0f + erff(y * 0.70710678118654752f)); }
__device__ __forceinline__ void ssm_phase_simple(Frame& F, const In& I, const bf16* U, bf16* YG) {
    const int lane = F.lane, w = F.wave;
    LAS unsigned* ul = (LAS unsigned*)(F.lds + w * 4096);
    LAS unsigned short* yl = (LAS unsigned short*)(F.lds + w * 4096 + 2048);
    LAS float* E = (LAS float*)(F.lds + 32768);
    for (int unit = F.vcu; unit < BATCH * 128; unit += F.G) {
        const int b = unit >> 7, g = unit & 127, p = lane;
        const float step = expf(I.log_step[g]), lre = I.lam_re[g * 64 + p], lim = I.lam_im[g * 64 + p];
        float lr, li; { const float er = expf(lre * step); float s, c; dsincos((double)(lim * step), s, c); lr = er * c; li = er * s; }
        float cfr, cfi; { const float nr = lr - 1.0f, ni = li, den = lre * lre + lim * lim; cfr = (nr * lre + ni * lim) / den; cfi = (ni * lre - nr * lim) / den; }
        float bbr[16], bbi[16], cr[16], ci[16];
#pragma unroll
        for (int h4 = 0; h4 < 4; ++h4) { const f32x4 br = *(const GAS f32x4*)(I.b_re + (size_t)(g * 64 + p) * 16 + 4 * h4), bi = *(const GAS f32x4*)(I.b_im + (size_t)(g * 64 + p) * 16 + 4 * h4);
#pragma unroll
            for (int e = 0; e < 4; ++e) { bbr[4 * h4 + e] = cfr * br[e] - cfi * bi[e]; bbi[4 * h4 + e] = cfr * bi[e] + cfi * br[e]; } }
#pragma unroll
        for (int h = 0; h < 16; ++h) { cr[h] = I.c_re[(size_t)(g * 16 + h) * 64 + p]; ci[h] = I.c_im[(size_t)(g * 16 + h) * 64 + p]; }
        float l5r = lr, l5i = li;
#pragma unroll
        for (int k = 0; k < 9; ++k) { const float nr = l5r * l5r - l5i * l5i, ni = 2.0f * l5r * l5i; l5r = nr; l5i = ni; }
        const float dsk = I.ssm_d[g * 16 + (lane >> 2)];
        const size_t row0 = (size_t)b * SEQ + w * 512;
        __syncthreads();
        float sr = 0.f, si = 0.f;
        for (int c = 0; c < 8; ++c) {
            { const GAS v4u* up = (const GAS v4u*)(U + (row0 + c * 64 + lane) * D_SSM + g * 16); const v4u a = up[0], bq = up[1];
              *(LAS v4u*)(ul + lane * 8) = a; *(LAS v4u*)(ul + lane * 8 + 4) = bq; }
            for (int tt = 0; tt < 64; ++tt) { const v4u a = *(const LAS v4u*)(ul + tt * 8), bq = *(const LAS v4u*)(ul + tt * 8 + 4);
                const float uu[16] = {bflo(a.x), bfhi(a.x), bflo(a.y), bfhi(a.y), bflo(a.z), bfhi(a.z), bflo(a.w), bfhi(a.w), bflo(bq.x), bfhi(bq.x), bflo(bq.y), bfhi(bq.y), bflo(bq.z), bfhi(bq.z), bflo(bq.w), bfhi(bq.w)};
                float zr = 0.f, zi = 0.f;
#pragma unroll
                for (int h = 0; h < 16; ++h) { zr += bbr[h] * uu[h]; zi += bbi[h] * uu[h]; }
                const float nr = lr * sr - li * si + zr, ni = lr * si + li * sr + zi; sr = nr; si = ni; }
        }
        E[(w * 64 + lane) * 2] = sr; E[(w * 64 + lane) * 2 + 1] = si;
        __syncthreads();
        sr = 0.f; si = 0.f;
        for (int wp = 0; wp < w; ++wp) { const float er = E[(wp * 64 + lane) * 2], ei = E[(wp * 64 + lane) * 2 + 1];
            const float nr = l5r * sr - l5i * si + er, ni = l5r * si + l5i * sr + ei; sr = nr; si = ni; }
        for (int c = 0; c < 8; ++c) {
            { const GAS v4u* up = (const GAS v4u*)(U + (row0 + c * 64 + lane) * D_SSM + g * 16); const v4u a = up[0], bq = up[1];
              *(LAS v4u*)(ul + lane * 8) = a; *(LAS v4u*)(ul + lane * 8 + 4) = bq; }
            for (int tt = 0; tt < 64; ++tt) { const v4u a = *(const LAS v4u*)(ul + tt * 8), bq = *(const LAS v4u*)(ul + tt * 8 + 4);
                const float uu[16] = {bflo(a.x), bfhi(a.x), bflo(a.y), bfhi(a.y), bflo(a.z), bfhi(a.z), bflo(a.w), bfhi(a.w), bflo(bq.x), bfhi(bq.x), bflo(bq.y), bfhi(bq.y), bflo(bq.z), bfhi(bq.z), bflo(bq.w), bfhi(bq.w)};
                float zr = 0.f, zi = 0.f;
#pragma unroll
                for (int h = 0; h < 16; ++h) { zr += bbr[h] * uu[h]; zi += bbi[h] * uu[h]; }
                const float nr = lr * sr - li * si + zr, ni = lr * si + li * sr + zi; sr = nr; si = ni;
                float v[16];
#pragma unroll
                for (int h = 0; h < 16; ++h) v[h] = cr[h] * sr - ci[h] * si;
#pragma unroll
                for (int i = 0; i < 8; ++i) { const bool hi = lane & 32; const float keep = hi ? v[i + 8] : v[i], send = hi ? v[i] : v[i + 8]; v[i] = keep + __shfl_xor(send, 32); }
#pragma unroll
                for (int i = 0; i < 4; ++i) { const bool hi = lane & 16; const float keep = hi ? v[i + 4] : v[i], send = hi ? v[i] : v[i + 4]; v[i] = keep + __shfl_xor(send, 16); }
#pragma unroll
                for (int i = 0; i < 2; ++i) { const bool hi = lane & 8; const float keep = hi ? v[i + 2] : v[i], send = hi ? v[i] : v[i + 2]; v[i] = keep + __shfl_xor(send, 8); }
                { const bool hi = lane & 4; const float keep = hi ? v[1] : v[0], send = hi ? v[0] : v[1]; v[0] = keep + __shfl_xor(send, 4); }
                float y = v[0]; y += __shfl_xor(y, 2); y += __shfl_xor(y, 1);
                const LAS unsigned short* ul16 = (const LAS unsigned short*)ul;
                y += dsk * bf2f(ul16[tt * 16 + (lane >> 2)]);
                y = erf_gelu(y);
                if ((lane & 3) == 0) yl[tt * 16 + (lane >> 2)] = (unsigned short)f2bf(y);
            }
            { const v4u a = *(const LAS v4u*)(yl + lane * 16), bq = *(const LAS v4u*)(yl + lane * 16 + 8);
              GAS v4u* yp = (GAS v4u*)(YG + (row0 + c * 64 + lane) * D_SSM + g * 16); yp[0] = a; yp[1] = bq; }
        }
    }
}


typedef float f32x16 __attribute__((ext_vector_type(16)));
typedef float f32x2v __attribute__((ext_vector_type(2)));
__device__ __forceinline__ bf16x8 pack8(float a0, float a1, float a2, float a3, float a4, float a5, float a6, float a7) {
    v4u w; w.x = pg8::cvt_pk_bf16(a0, a1); w.y = pg8::cvt_pk_bf16(a2, a3); w.z = pg8::cvt_pk_bf16(a4, a5); w.w = pg8::cvt_pk_bf16(a6, a7); return __builtin_bit_cast(bf16x8, w); }
__device__ __forceinline__ void ssm_phase_mfma(Frame& F, const In& I, const bf16* U, bf16* YG) {
    const int lane = F.lane, w = F.wave, n = lane & 31, h = lane >> 5, t16 = lane & 15, kq = lane >> 4;
    LAS unsigned* St = (LAS unsigned*)(F.lds + w * 8704);
    LAS float* E = (LAS float*)(F.lds + 8 * 8704);
    for (int unit = F.vcu; unit < 256; unit += F.G) {
        const int g = unit >> 1, bp = unit & 1;
        const float step = expf(I.log_step[g]);
        float lr[2], li[2], l5r[2], l5i[2]; bf16x8 Bf[4];
#pragma unroll
        for (int q = 0; q < 2; ++q) { const int p = n + 32 * q; const float lre = I.lam_re[g * 64 + p], lim = I.lam_im[g * 64 + p];
            { const float er = expf(lre * step); float s, c; dsincos((double)(lim * step), s, c); lr[q] = er * c; li[q] = er * s; }
            const float nr = lr[q] - 1.0f, ni = li[q], den = lre * lre + lim * lim, cfr = (nr * lre + ni * lim) / den, cfi = (ni * lre - nr * lim) / den;
            float a = lr[q], bq = li[q];
#pragma unroll
            for (int k = 0; k < 9; ++k) { const float xr = a * a - bq * bq, xi = 2.0f * a * bq; a = xr; bq = xi; }
            l5r[q] = a; l5i[q] = bq;
            const GAS f32x4* brp = (const GAS f32x4*)(I.b_re + (size_t)(g * 64 + p) * 16 + 8 * h); const GAS f32x4* bip = (const GAS f32x4*)(I.b_im + (size_t)(g * 64 + p) * 16 + 8 * h);
            const f32x4 br0 = brp[0], br1 = brp[1], bi0 = bip[0], bi1 = bip[1];
            const f32x4 re0 = cfr * br0 - cfi * bi0, re1 = cfr * br1 - cfi * bi1, im0 = cfr * bi0 + cfi * br0, im1 = cfr * bi1 + cfi * br1;
            Bf[q] = pack8(re0[0], re0[1], re0[2], re0[3], re1[0], re1[1], re1[2], re1[3]);
            Bf[2 + q] = pack8(im0[0], im0[1], im0[2], im0[3], im1[0], im1[1], im1[2], im1[3]); }
        bf16x8 Cf[4];
#pragma unroll
        for (int ks = 0; ks < 4; ++ks) { const f32x4 c_r = *(const GAS f32x4*)(I.c_re + (size_t)(g * 16 + t16) * 64 + 16 * ks + 4 * kq), c_i = *(const GAS f32x4*)(I.c_im + (size_t)(g * 16 + t16) * 64 + 16 * ks + 4 * kq);
            Cf[ks] = pack8(c_r[0], -c_i[0], c_r[1], -c_i[1], c_r[2], -c_i[2], c_r[3], -c_i[3]); }
        const f32x4 dsk = *(const GAS f32x4*)(I.ssm_d + g * 16 + 4 * kq);
        const int aseq = (n >> 2) & 1, atok = 4 * (n >> 3) + (n & 3);
        const bf16* ua = U + ((size_t)(2 * bp + aseq) * SEQ + w * 512 + atok) * D_SSM + g * 16 + 8 * h;
        __syncthreads();
        float s0r = 0.f, s0i = 0.f, s1r = 0.f, s1i = 0.f;
        const f32x16 zero16 = {0.f, 0.f, 0.f, 0.f, 0.f, 0.f, 0.f, 0.f, 0.f, 0.f, 0.f, 0.f, 0.f, 0.f, 0.f, 0.f};
        bf16x8 a_nx = *(const GAS bf16x8*)(ua);
        for (int st = 0; st < 32; ++st) {
            const bf16x8 a = a_nx;
            a_nx = *(const GAS bf16x8*)(ua + (size_t)((st + 1) & 31) * 16 * D_SSM);
            const f32x16 z0 = __builtin_amdgcn_mfma_f32_32x32x16_bf16(a, Bf[0], zero16, 0, 0, 0), z1 = __builtin_amdgcn_mfma_f32_32x32x16_bf16(a, Bf[1], zero16, 0, 0, 0);
            const f32x16 z2 = __builtin_amdgcn_mfma_f32_32x32x16_bf16(a, Bf[2], zero16, 0, 0, 0), z3 = __builtin_amdgcn_mfma_f32_32x32x16_bf16(a, Bf[3], zero16, 0, 0, 0);
#pragma unroll
            for (int r = 0; r < 16; ++r) { const float ar = lr[0] * s0r - li[0] * s0i + z0[r], ai = lr[0] * s0i + li[0] * s0r + z2[r]; s0r = ar; s0i = ai;
                                           const float br = lr[1] * s1r - li[1] * s1i + z1[r], bi = lr[1] * s1i + li[1] * s1r + z3[r]; s1r = br; s1i = bi; }
        }
        *(LAS f32x4*)(E + (w * 64 + lane) * 4) = (f32x4){s0r, s0i, s1r, s1i};
        __syncthreads();
        s0r = 0.f; s0i = 0.f; s1r = 0.f; s1i = 0.f;
        for (int wp = 0; wp < w; ++wp) { const f32x4 e = *(const LAS f32x4*)(E + (wp * 64 + lane) * 4);
            const float ar = l5r[0] * s0r - l5i[0] * s0i + e[0], ai = l5r[0] * s0i + l5i[0] * s0r + e[1]; s0r = ar; s0i = ai;
            const float br = l5r[1] * s1r - l5i[1] * s1i + e[2], bi = l5r[1] * s1i + l5i[1] * s1r + e[3]; s1r = br; s1i = bi; }
        const size_t uoff0 = ((size_t)(2 * bp) * SEQ + w * 512 + t16) * D_SSM + g * 16 + 4 * kq;
        a_nx = *(const GAS bf16x8*)(ua);
        unsigned long long uw_nx[2] = {*(const GAS unsigned long long*)(U + uoff0), *(const GAS unsigned long long*)(U + uoff0 + (size_t)SEQ * D_SSM)};
        for (int st = 0; st < 32; ++st) {
            const bf16x8 a = a_nx; const unsigned long long uw_cur[2] = {uw_nx[0], uw_nx[1]};
            { const size_t nx = (size_t)((st + 1) & 31) * 16 * D_SSM; a_nx = *(const GAS bf16x8*)(ua + nx);
              uw_nx[0] = *(const GAS unsigned long long*)(U + uoff0 + nx); uw_nx[1] = *(const GAS unsigned long long*)(U + uoff0 + (size_t)SEQ * D_SSM + nx); }
            const f32x16 z0 = __builtin_amdgcn_mfma_f32_32x32x16_bf16(a, Bf[0], zero16, 0, 0, 0), z1 = __builtin_amdgcn_mfma_f32_32x32x16_bf16(a, Bf[1], zero16, 0, 0, 0);
            const f32x16 z2 = __builtin_amdgcn_mfma_f32_32x32x16_bf16(a, Bf[2], zero16, 0, 0, 0), z3 = __builtin_amdgcn_mfma_f32_32x32x16_bf16(a, Bf[3], zero16, 0, 0, 0);
#pragma unroll
            for (int r = 0; r < 16; ++r) { const float ar = lr[0] * s0r - li[0] * s0i + z0[r], ai = lr[0] * s0i + li[0] * s0r + z2[r]; s0r = ar; s0i = ai;
                                           const float br = lr[1] * s1r - li[1] * s1i + z1[r], bi = lr[1] * s1i + li[1] * s1r + z3[r]; s1r = br; s1i = bi;
                                           St[(h * 16 + r) * 68 + n] = pg8::cvt_pk_bf16(s0r, s0i); St[(h * 16 + r) * 68 + 32 + n] = pg8::cvt_pk_bf16(s1r, s1i); }
#pragma unroll
            for (int s = 0; s < 2; ++s) { f32x4 acc = (f32x4){0.f, 0.f, 0.f, 0.f};
#pragma unroll
                for (int ks = 0; ks < 4; ++ks) { const bf16x8 sb = *(const LAS bf16x8*)(St + (s * 16 + t16) * 68 + 16 * ks + 4 * kq); acc = __builtin_amdgcn_mfma_f32_16x16x32_bf16(Cf[ks], sb, acc, 0, 0, 0); }
                const size_t off = uoff0 + (size_t)s * SEQ * D_SSM + (size_t)st * 16 * D_SSM;
                const unsigned long long uw = uw_cur[s];
                const unsigned u01 = (unsigned)uw, u23 = (unsigned)(uw >> 32);
                const pg8::f32x2 y01 = pg8::gelu_pk((pg8::f32x2){acc[0] + dsk[0] * bflo(u01), acc[1] + dsk[1] * bfhi(u01)});
                const pg8::f32x2 y23 = pg8::gelu_pk((pg8::f32x2){acc[2] + dsk[2] * bflo(u23), acc[3] + dsk[3] * bfhi(u23)});
                *(GAS unsigned long long*)(YG + off) = (unsigned long long)pg8::cvt_pk_bf16(y01.x, y01.y) | ((unsigned long long)pg8::cvt_pk_bf16(y23.x, y23.y) << 32); }
        }
    }
}


__device__ __forceinline__ void attn_phase_mfma(Frame& F, const bf16* Q, const bf16* K, const bf16* V, bf16* O, float* SSA, const float* sinks) {
    constexpr int KRS = 72, VRS = 260;
    LAS unsigned short* Ks = (LAS unsigned short*)(F.lds);
    LAS unsigned short* Vt = (LAS unsigned short*)(F.lds + 36864);
    const int lane = F.lane, w = F.wave, q = lane & 31, h = lane >> 5;
    for (int unit = F.vcu; unit < BATCH * 32 * 4; unit += F.G) {
        const int kvh = unit & 3, nb = (unit >> 2) & 31, b = unit >> 7;
        const size_t tok0 = (size_t)b * SEQ + nb * 128;
        __syncthreads();
        for (int c = F.tid; c < 2048; c += NWAVES * 64) { const int kk = c >> 3, ch = c & 7;
            v4u kv = (v4u){0u, 0u, 0u, 0u}, vv = (v4u){0u, 0u, 0u, 0u};
            if (nb > 0 || kk >= 128) { const size_t r = tok0 - 128 + kk; kv = *(const GAS v4u*)(K + r * D_KV + kvh * 64 + ch * 8); vv = *(const GAS v4u*)(V + r * D_KV + kvh * 64 + ch * 8); }
            *(LAS v4u*)(Ks + kk * KRS + ch * 8) = kv;
            LAS unsigned short* vd = Vt + (ch * 8) * VRS + kk;
            vd[0 * VRS] = (unsigned short)vv.x; vd[1 * VRS] = (unsigned short)(vv.x >> 16); vd[2 * VRS] = (unsigned short)vv.y; vd[3 * VRS] = (unsigned short)(vv.y >> 16);
            vd[4 * VRS] = (unsigned short)vv.z; vd[5 * VRS] = (unsigned short)(vv.z >> 16); vd[6 * VRS] = (unsigned short)vv.w; vd[7 * VRS] = (unsigned short)(vv.w >> 16); }
        __syncthreads();
        const int hq = kvh * 8 + w; const float sink2 = sinks[hq] * LOG2E;
        bf16x8 qn[4];
#pragma unroll
        for (int ds = 0; ds < 4; ++ds) qn[ds] = *(const GAS bf16x8*)(Q + (tok0 + q) * D_ATTN + hq * 64 + 16 * ds + 8 * h);
        for (int mt = 0; mt < 4; ++mt) {
            const size_t row = tok0 + 32 * mt + q;
            bf16x8 qf[4];
#pragma unroll
            for (int ds = 0; ds < 4; ++ds) { qf[ds] = qn[ds]; qn[ds] = *(const GAS bf16x8*)(Q + (tok0 + 32 * ((mt + 1) & 3) + q) * D_ATTN + hq * 64 + 16 * ds + 8 * h); }
            f32x16 s[5];
#pragma unroll
            for (int t = 0; t < 5; ++t) { s[t] = (f32x16){0.f, 0.f, 0.f, 0.f, 0.f, 0.f, 0.f, 0.f, 0.f, 0.f, 0.f, 0.f, 0.f, 0.f, 0.f, 0.f};
#pragma unroll
                for (int ds = 0; ds < 4; ++ds) { const bf16x8 kf = *(const LAS bf16x8*)(Ks + (32 * (mt + t) + q) * KRS + 16 * ds + 8 * h); s[t] = __builtin_amdgcn_mfma_f32_32x32x16_bf16(kf, qf[ds], s[t], 0, 0, 0); } }
#pragma unroll
            for (int r = 0; r < 16; ++r) { const int i = 8 * (r >> 2) + 4 * h + (r & 3); if (i <= q) s[0][r] = -INFINITY; if (i > q) s[4][r] = -INFINITY; }
            if (nb == 0) {
#pragma unroll
                for (int t = 0; t < 4; ++t) if (mt + t < 4) {
#pragma unroll
                    for (int r = 0; r < 16; ++r) s[t][r] = -INFINITY; } }
            float mx = sink2;
#pragma unroll
            for (int t = 0; t < 5; ++t)
#pragma unroll
                for (int r = 0; r < 16; ++r) mx = fmaxf(mx, s[t][r]);
            mx = fmaxf(mx, __shfl_xor(mx, 32));
            float sum = 0.f;
#pragma unroll
            for (int t = 0; t < 5; ++t)
#pragma unroll
                for (int r = 0; r < 16; ++r) { const float p = exp2f(s[t][r] - mx); s[t][r] = p; sum += p; }
            sum += __shfl_xor(sum, 32);
            const float inv = 1.0f / (sum + exp2f(sink2 - mx));
            f32x16 o0 = (f32x16){0.f, 0.f, 0.f, 0.f, 0.f, 0.f, 0.f, 0.f, 0.f, 0.f, 0.f, 0.f, 0.f, 0.f, 0.f, 0.f}, o1 = o0;
#pragma unroll
            for (int t = 0; t < 5; ++t)
#pragma unroll
                for (int k2 = 0; k2 < 2; ++k2) {
                    const bf16x8 pb = pack8(s[t][8 * k2 + 0], s[t][8 * k2 + 1], s[t][8 * k2 + 2], s[t][8 * k2 + 3], s[t][8 * k2 + 4], s[t][8 * k2 + 5], s[t][8 * k2 + 6], s[t][8 * k2 + 7]);
                    const int kb = 32 * (mt + t) + 16 * k2 + 4 * h;
                    typedef unsigned u32x2v __attribute__((ext_vector_type(2)));
                    const u32x2v a0 = *(const LAS u32x2v*)(Vt + q * VRS + kb), a1 = *(const LAS u32x2v*)(Vt + q * VRS + kb + 8);
                    const u32x2v c0 = *(const LAS u32x2v*)(Vt + (q + 32) * VRS + kb), c1 = *(const LAS u32x2v*)(Vt + (q + 32) * VRS + kb + 8);
                    const bf16x8 va0 = __builtin_bit_cast(bf16x8, (v4u){a0.x, a0.y, a1.x, a1.y}), va1 = __builtin_bit_cast(bf16x8, (v4u){c0.x, c0.y, c1.x, c1.y});
                    o0 = __builtin_amdgcn_mfma_f32_32x32x16_bf16(va0, pb, o0, 0, 0, 0); o1 = __builtin_amdgcn_mfma_f32_32x32x16_bf16(va1, pb, o1, 0, 0, 0); }
            float ss = 0.f;
            bf16* orow = O + row * DM + hq * 64 + 4 * h;
#pragma unroll
            for (int a = 0; a < 4; ++a) {
                const unsigned w0 = pg8::cvt_pk_bf16(o0[4 * a] * inv, o0[4 * a + 1] * inv), w1 = pg8::cvt_pk_bf16(o0[4 * a + 2] * inv, o0[4 * a + 3] * inv);
                const unsigned x0 = pg8::cvt_pk_bf16(o1[4 * a] * inv, o1[4 * a + 1] * inv), x1 = pg8::cvt_pk_bf16(o1[4 * a + 2] * inv, o1[4 * a + 3] * inv);
                ss += bflo(w0) * bflo(w0) + bfhi(w0) * bfhi(w0) + bflo(w1) * bflo(w1) + bfhi(w1) * bfhi(w1) + bflo(x0) * bflo(x0) + bfhi(x0) * bfhi(x0) + bflo(x1) * bflo(x1) + bfhi(x1) * bfhi(x1);
                *(GAS unsigned long long*)(orow + 8 * a) = (unsigned long long)w0 | ((unsigned long long)w1 << 32);
                *(GAS unsigned long long*)(orow + 32 + 8 * a) = (unsigned long long)x0 | ((unsigned long long)x1 << 32); }
            ss += __shfl_xor(ss, 32);
            if (h == 0) SSA[row * 32 + hq] = ss;
        }
    }
}

struct Args { const float* in[24]; float* out; unsigned char* ws; };
__global__ void __launch_bounds__(NWAVES * 64, 2) hymba_fwd(Args args) {
    extern __shared__ __attribute__((aligned(16))) unsigned char lds[];
    Frame F;
    F.lds = (LAS unsigned char*)lds;
    F.MISC = (volatile LAS unsigned*)(F.lds + MISC_OFF);
    F.tid = threadIdx.x; F.lane = F.tid & 63; F.wave = __builtin_amdgcn_readfirstlane(F.tid >> 6);
    F.G = gridDim.x; { const int bx = blockIdx.x; F.vcu = (F.G % 8 == 0) ? (bx % 8) * (F.G / 8) + bx / 8 : bx; }
    unsigned char* ws = args.ws;
    F.ctl = (gu32*)(ws + WS_CTL);
    In I;
    I.x = args.in[0]; I.c = args.in[1]; I.w_ada = args.in[2]; I.b_ada = args.in[3]; I.norm1_g = args.in[4]; I.w_in = args.in[5]; I.sinks = args.in[6];
    I.lam_re = args.in[7]; I.lam_im = args.in[8]; I.log_step = args.in[9]; I.b_re = args.in[10]; I.b_im = args.in[11]; I.c_re = args.in[12]; I.c_im = args.in[13];
    I.ssm_d = args.in[14]; I.w_glu = args.in[15]; I.b_glu = args.in[16]; I.attn_g = args.in[17]; I.ssm_g = args.in[18]; I.w_out = args.in[19]; I.norm2_g = args.in[20];
    I.w_ff1 = args.in[21]; I.w_ff2 = args.in[22]; I.final_g = args.in[23];
    float* out = args.out;
    const float* mod = (const float*)(ws + WS_MOD);
    bf16 *Wi = (bf16*)(ws + WS_WIN), *Wg = (bf16*)(ws + WS_WGLU), *Wo = (bf16*)(ws + WS_WOUT), *W1 = (bf16*)(ws + WS_WFF1), *W2 = (bf16*)(ws + WS_WFF2);
    bf16 *H = (bf16*)(ws + WS_H), *Qb = (bf16*)(ws + WS_Q), *Kb = (bf16*)(ws + WS_K), *Vb = (bf16*)(ws + WS_V), *Ub = (bf16*)(ws + WS_U);
    bf16 *MIX = (bf16*)(ws + WS_MIX), *YG = (bf16*)(ws + WS_YG), *HID = (bf16*)(ws + WS_HID);
    float *SSA = (float*)(ws + WS_SSA), *SSS = (float*)(ws + WS_SSS);
    const float* rcos = (const float*)(ws + WS_ROPE); const float* rsin = rcos + SEQ * 32;
    for (int u = F.tid; u < (LDS_BYTES - LDSCTL_OFF) / 4; u += NWAVES * 64) ((LAS unsigned*)(F.lds + LDSCTL_OFF))[u] = 0u;
    __syncthreads();
    XcdBarrier bar = xcd_barrier_post((unsigned*)(F.ctl + CW_BAR), F.MISC + 8);
    const int gw = F.vcu * NWAVES + F.wave, NGW = F.G * NWAVES;

    p0_prologue(F, I, ws);
    xcd_barrier(bar);
    for (int m = gw; m < M; m += NGW) { const float* mb = mod + (size_t)(m >> 12) * NMODC; norm_mod_row(I.x + (size_t)m * DM, I.norm1_g, mb + DM, mb, H + (size_t)m * DM, F.lane); }
    xcd_barrier(bar);
    if (F.G > GEMM1_WGS && (int)blockIdx.x >= GEMM1_WGS) spare_convert(F, I, ws, (int)blockIdx.x - GEMM1_WGS, F.G - GEMM1_WGS);
    else { const int gg = F.G > GEMM1_WGS ? GEMM1_WGS : F.G;
      pg8::Gemm g{H, Wi, M, D_IN, DM}; pg8::StaticOrder S; S.init(M, D_IN, gg, (int)blockIdx.x, WGM_IN);
      pg8::EpiIn E{Qb, Kb, Vb, Ub, rcos, rsin, 0.125f * LOG2E};
      pg8::gemm_phase<pg8::EpiIn, pg8::StaticOrder, true, true>(F.lds + RING_OFF, g, S, E); }
    xcd_barrier(bar);
    attn_phase_mfma(F, Qb, Kb, Vb, MIX, SSA, I.sinks);
    ssm_phase_mfma(F, I, Ub, YG);
    xcd_barrier(bar);
    { pg8::Gemm g{YG, Wg, M, D_SSM, D_SSM}; pg8::StaticOrder S; S.init(M, D_SSM, F.G, (int)blockIdx.x, WGM_GLU);
      pg8::EpiGlu E{YG, I.b_glu, MIX, SSS};
      pg8::gemm_phase<pg8::EpiGlu, pg8::StaticOrder, true, true>(F.lds + RING_OFF, g, S, E); }
    xcd_barrier(bar);
    { pg8::Gemm g{MIX, Wo, M, DM, DM}; pg8::StaticOrder S; S.init(M, DM, F.G, (int)blockIdx.x, WGM_OUT);
      pg8::Unit u0; S.next(0, u0);
      LAS float* rat = (LAS float*)(F.lds + LDSCTL_OFF + 1024); LAS float* rsc = rat + 256;
      { const int row = F.tid >> 1, hf = F.tid & 1; const GAS f32x4* pp = (const GAS f32x4*)((hf ? SSS : SSA) + (size_t)(u0.pm * 256 + row) * 32);
        f32x4 s4 = pp[0];
#pragma unroll
        for (int j = 1; j < 8; ++j) s4 += pp[j];
        const float r = 1.0f / sqrtf(((s4.x + s4.y) + (s4.z + s4.w)) * (1.0f / 2048.0f) + EPS), ro = __shfl_xor(r, 1);
        if (hf == 0) rat[row] = r / ro; else rsc[row] = r; }
      __syncthreads();
      pg8::EpiResMix E{I.x, out, mod + 2 * DM, rat, rsc};
      pg8::gemm_phase<pg8::EpiResMix, pg8::StaticOrder, true, true>(F.lds + RING_OFF, g, S, E); }
    xcd_barrier(bar);
    for (int m = gw; m < M; m += NGW) { const float* mb = mod + (size_t)(m >> 12) * NMODC; norm_mod_row(out + (size_t)m * DM, I.norm2_g, mb + 4 * DM, mb + 3 * DM, H + (size_t)m * DM, F.lane); }
    xcd_barrier(bar);
    { pg8::Gemm g{H, W1, M, D_FF, DM}; pg8::StaticOrder S; S.init(M, D_FF, F.G, (int)blockIdx.x, WGM_FF1);
      pg8::EpiSqRelu E{HID, D_FF};
      pg8::gemm_phase<pg8::EpiSqRelu, pg8::StaticOrder, true, true>(F.lds + RING_OFF, g, S, E); }
    xcd_barrier(bar);
    { pg8::Gemm g{HID, W2, M, DM, D_FF}; pg8::StaticOrder S; S.init(M, DM, F.G, (int)blockIdx.x, WGM_FF2);
      pg8::EpiRes E{out, out, mod + 5 * DM};
      pg8::gemm_phase<pg8::EpiRes, pg8::StaticOrder, true, true>(F.lds + RING_OFF, g, S, E); }
    xcd_barrier(bar);
    for (int m = gw; m < M; m += NGW) final_norm_row(out + (size_t)m * DM, I.final_g, F.lane);
}

extern "C" void kernel_launch(void* const* d_in, const int* in_sizes, int n_in, void* d_out, int out_size, void* d_ws, size_t ws_size, hipStream_t stream) {
    static int grid = 0;
    if (grid == 0) {
        if (n_in != 24 || in_sizes[0] != M * DM || out_size != M * DM || ws_size < WS_END) { fprintf(stderr, "kernel_launch: unexpected shapes: n_in %d in0 %d out %d ws %zu (need %zu); nothing launched\n", n_in, n_in > 0 ? in_sizes[0] : -1, out_size, ws_size, (size_t)WS_END); grid = -1; return; }
        int dev = 0, cus = 0, per_cu = 0;
        if (hipGetDevice(&dev) != hipSuccess || hipDeviceGetAttribute(&cus, hipDeviceAttributeMultiprocessorCount, dev) != hipSuccess) { grid = -1; return; }
        if (hipFuncSetAttribute((const void*)hymba_fwd, hipFuncAttributeMaxDynamicSharedMemorySize, LDS_BYTES) != hipSuccess) { fprintf(stderr, "kernel_launch: hipFuncSetAttribute failed\n"); grid = -1; return; }
        if (hipOccupancyMaxActiveBlocksPerMultiprocessor(&per_cu, (const void*)hymba_fwd, NWAVES * 64, LDS_BYTES) != hipSuccess || per_cu < 1)
            fprintf(stderr, "kernel_launch: note: occupancy query reports %d workgroups per CU\n", per_cu);
        (void)hipGetLastError();
        grid = cus;
    }
    if (grid < 0) return;
    if (hipMemsetAsync((char*)d_ws + WS_CTL, 0, CTL_ZERO_BYTES, stream) != hipSuccess) return;
    Args a{};
    for (int i = 0; i < 24; ++i) a.in[i] = (const float*)d_in[i];
    a.out = (float*)d_out; a.ws = (unsigned char*)d_ws;
    hipLaunchKernelGGL(hymba_fwd, dim3(grid), dim3(NWAVES * 64), LDS_BYTES, stream, a);
}
```
